# Optimizing an MI355X kernel written in HIP

```python
import math
import jax, jax.numpy as jnp
from jax import lax
import numpy as np

D_MODEL = 1024
BATCH = 8
SEQ = 2048
DEPTH = 1
DEC_BATCH = 128
DEC_SEQ = 1
PAST_LEN = 16384
PAGE_SIZE = 128

EPS = 1e-6
S5_WIDTH = D_MODEL
S5_GROUP = 16
S5_GROUPS = S5_WIDTH // S5_GROUP
S5_STATE = 64
S5_DT_MIN = 1e-3
S5_DT_MAX = 1e-1
M_EXPAND = 2
M_INNER = M_EXPAND * D_MODEL
M_HEADDIM = 64
M_HEADS = M_INNER // M_HEADDIM
M_GROUPS = 4
M_HPG = M_HEADS // M_GROUPS
M_STATE = 128
M_CONV = 4
M_CONV_DIM = M_INNER + 2 * M_GROUPS * M_STATE
M_CHUNK = 128
M_DT_MIN = 1e-3
M_DT_MAX = 1e-1
D_FF = -(-8 * D_MODEL // (3 * 256)) * 256
OFF_Z = S5_WIDTH
OFF_XBC = OFF_Z + M_INNER
OFF_DT = OFF_XBC + M_CONV_DIM
OFF_GA = OFF_DT + M_HEADS
OFF_GB = OFF_GA + D_MODEL
IN_COLS = OFF_GB + D_MODEL

kernel_name = "hybrid_s5_ssd_gated_decoder_step"


def _rmsnorm(x, g):
    x32 = x.astype(jnp.float32)
    r = x32 * lax.rsqrt(jnp.mean(x32 * x32, axis=-1, keepdims=True) + EPS)
    return (r * g.astype(jnp.float32)).astype(x.dtype)


def _modulate(h, shift, scale):
    return h * (1.0 + scale[:, None, :]) + shift[:, None, :]


def _cplx_affine(e1, e2):
    a1r, a1i, b1r, b1i = e1
    a2r, a2i, b2r, b2i = e2
    return (a2r * a1r - a2i * a1i,
            a2r * a1i + a2i * a1r,
            a2r * b1r - a2i * b1i + b2r,
            a2r * b1i + a2i * b1r + b2i)


def _s5_mixer(u, h0_re, h0_im, lam_re, lam_im, log_dt, b_re, b_im, c_re, c_im, d_skip, w_glu, b_glu):
    bsz, L, _ = u.shape
    u32 = u.astype(jnp.float32)
    lr = lam_re.astype(jnp.float32)
    li = lam_im.astype(jnp.float32)
    dt = jnp.exp(log_dt.astype(jnp.float32))[:, None]
    mag = jnp.exp(lr * dt)
    abar_re = mag * jnp.cos(li * dt)
    abar_im = mag * jnp.sin(li * dt)
    den = lr * lr + li * li
    nr = abar_re - 1.0
    ni = abar_im
    f_re = (nr * lr + ni * li) / den
    f_im = (ni * lr - nr * li) / den
    br = b_re.astype(jnp.float32)
    bi = b_im.astype(jnp.float32)
    bbar_re = f_re[..., None] * br - f_im[..., None] * bi
    bbar_im = f_re[..., None] * bi + f_im[..., None] * br
    ug = u32.reshape(bsz, L, S5_GROUPS, S5_GROUP)
    bu_re = jnp.einsum("blgh,gnh->blgn", ug, bbar_re)
    bu_im = jnp.einsum("blgh,gnh->blgn", ug, bbar_im)
    shp = (bsz, L, S5_GROUPS, S5_STATE)
    a_re = jnp.broadcast_to(abar_re, shp)
    a_im = jnp.broadcast_to(abar_im, shp)
    acr, aci, bcr, bci = lax.associative_scan(_cplx_affine, (a_re, a_im, bu_re, bu_im), axis=1)
    h0r = h0_re.astype(jnp.float32)[:, None]
    h0i = h0_im.astype(jnp.float32)[:, None]
    h_re = bcr + acr * h0r - aci * h0i
    h_im = bci + acr * h0i + aci * h0r
    y = (jnp.einsum("ghn,blgn->blgh", c_re.astype(jnp.float32), h_re)
         - jnp.einsum("ghn,blgn->blgh", c_im.astype(jnp.float32), h_im)).reshape(bsz, L, S5_WIDTH)
    y = (y + d_skip.astype(jnp.float32) * u32).astype(u.dtype)
    ya = jax.nn.gelu(y)
    out = ya * jax.nn.sigmoid(ya @ w_glu + b_glu)
    return out, h_re[:, -1], h_im[:, -1]


def _ssd(xs, dt, a_head, bm, cm, h0):
    bsz, L = xs.shape[0], xs.shape[1]
    q = M_CHUNK if L % M_CHUNK == 0 else L
    nc = L // q
    xdt = (xs * dt[..., None]).reshape(bsz, nc, q, M_GROUPS, M_HPG, M_HEADDIM)
    a = jnp.moveaxis((dt * a_head).reshape(bsz, nc, q, M_GROUPS, M_HPG), 2, -1)
    bc = bm.reshape(bsz, nc, q, M_GROUPS, M_STATE)
    cc = cm.reshape(bsz, nc, q, M_GROUPS, M_STATE)
    a_cs = jnp.cumsum(a, axis=-1)
    causal = jnp.tril(jnp.ones((q, q), dtype=bool))
    decay_in = jnp.exp(jnp.where(causal, a_cs[..., :, None] - a_cs[..., None, :], -jnp.inf))
    cb = jnp.einsum("bclgn,bcsgn->bcgls", cc, bc)
    y_diag = jnp.einsum("bcgls,bcgrls,bcsgrp->bclgrp", cb, decay_in, xdt)
    decay_to_end = jnp.exp(a_cs[..., -1:] - a_cs)
    chunk_states = jnp.einsum("bclgn,bcgrl,bclgrp->bcgrpn", bc, decay_to_end, xdt)
    chunk_decay = jnp.exp(a_cs[..., -1])

    def step(h, inp):
        dec, st = inp
        return dec[..., None, None] * h + st, h

    h_final, h_enter = lax.scan(step, h0, (jnp.moveaxis(chunk_decay, 1, 0), jnp.moveaxis(chunk_states, 1, 0)))
    h_enter = jnp.moveaxis(h_enter, 0, 1)
    y_off = jnp.einsum("bclgn,bcgrpn,bcgrl->bclgrp", cc, h_enter, jnp.exp(a_cs))
    y = (y_diag + y_off).reshape(bsz, L, M_GROUPS, M_HPG, M_HEADDIM)
    return y, h_final


def _ssd_mixer(z, xbc, dt_raw, conv_buf, h0, conv_w, conv_b, dt_bias, a_log, d_skip, norm_w):
    bsz, L, _ = xbc.shape
    xbc_full = jnp.concatenate([conv_buf.astype(xbc.dtype), xbc], axis=1)
    conv = conv_b + sum(xbc_full[:, k:k + L] * conv_w[k] for k in range(M_CONV))
    new_buf = xbc_full[:, -(M_CONV - 1):]
    act = jax.nn.silu(conv).astype(jnp.float32)
    xs = act[..., :M_INNER].reshape(bsz, L, M_GROUPS, M_HPG, M_HEADDIM)
    bm = act[..., M_INNER:M_INNER + M_GROUPS * M_STATE].reshape(bsz, L, M_GROUPS, M_STATE)
    cm = act[..., M_INNER + M_GROUPS * M_STATE:].reshape(bsz, L, M_GROUPS, M_STATE)
    dt = jax.nn.softplus(dt_raw.astype(jnp.float32) + dt_bias.astype(jnp.float32)).reshape(bsz, L, M_GROUPS, M_HPG)
    a_head = -jnp.exp(a_log.astype(jnp.float32)).reshape(M_GROUPS, M_HPG)
    h0g = h0.astype(jnp.float32).reshape(bsz, M_GROUPS, M_HPG, M_HEADDIM, M_STATE)
    y, h_final = _ssd(xs, dt, a_head, bm, cm, h0g)
    y = y + d_skip.astype(jnp.float32).reshape(M_GROUPS, M_HPG)[:, :, None] * xs
    y = y.reshape(bsz, L, M_INNER).astype(z.dtype)
    y = _rmsnorm(y * jax.nn.silu(z), norm_w)
    return y, h_final.reshape(bsz, M_HEADS, M_HEADDIM, M_STATE), new_buf


def _layer(x, c, h5_re, h5_im, h_ssm, conv_buf, p):
    mod = jax.nn.silu(c) @ p["w_ada"] + p["b_ada"]
    sh_m, sc_m, gt_m, sh_f, sc_f, gt_f = jnp.split(mod, 6, axis=-1)
    h = _modulate(_rmsnorm(x, p["norm_pre_mix"]), sh_m, sc_m)
    proj = h @ p["w_in"]
    u = proj[..., :OFF_Z]
    z = proj[..., OFF_Z:OFF_XBC]
    xbc = proj[..., OFF_XBC:OFF_DT]
    dt_raw = proj[..., OFF_DT:OFF_GA]
    g_a = jax.nn.sigmoid(proj[..., OFF_GA:OFF_GB])
    g_b = jax.nn.sigmoid(proj[..., OFF_GB:])
    ya, h5_re_new, h5_im_new = _s5_mixer(u, h5_re, h5_im, p["s5_lam_re"], p["s5_lam_im"], p["s5_log_dt"],
                                         p["s5_b_re"], p["s5_b_im"], p["s5_c_re"], p["s5_c_im"],
                                         p["s5_d"], p["s5_w_glu"], p["s5_b_glu"])
    yb, h_ssm_new, conv_new = _ssd_mixer(z, xbc, dt_raw, conv_buf, h_ssm, p["m_conv_w"], p["m_conv_b"],
                                         p["m_dt_bias"], p["m_a_log"], p["m_d"], p["m_norm"])
    merged = g_a * (ya @ p["w_branch_s5"]) + g_b * (yb @ p["w_branch_ssd"])
    mix = merged @ p["w_out"]
    x = x + gt_m[:, None, :] * _rmsnorm(mix, p["norm_post_mix"])
    h = _modulate(_rmsnorm(x, p["norm_pre_ffn"]), sh_f, sc_f)
    gu = h @ p["w_ffn_in"]
    f = (jax.nn.silu(gu[..., :D_FF]) * gu[..., D_FF:]) @ p["w_ffn_out"]
    x = x + gt_f[:, None, :] * _rmsnorm(f, p["norm_post_ffn"])
    return x, h5_re_new.astype(x.dtype), h5_im_new.astype(x.dtype), h_ssm_new.astype(x.dtype), conv_new.astype(x.dtype)


def setup_inputs(seed: int = 0) -> dict:
    key = jax.random.key(seed)
    ks = jax.random.split(key, 40)
    f32 = jnp.float32
    nrm = lambda k, shape, s: jax.random.normal(k, shape, f32) * s
    D = DEPTH
    n_idx = jnp.arange(S5_STATE, dtype=f32)
    dt_m = jnp.exp(jax.random.uniform(ks[30], (D, M_HEADS), f32, math.log(M_DT_MIN), math.log(M_DT_MAX)))
    return {
        "x_prompt": nrm(ks[0], (BATCH, SEQ, D_MODEL), 1.0),
        "x_sample": nrm(ks[1], (DEC_BATCH, DEC_SEQ, D_MODEL), 1.0),
        "state_s5_re": nrm(ks[2], (D, DEC_BATCH, S5_GROUPS, S5_STATE), 0.3),
        "state_s5_im": nrm(ks[3], (D, DEC_BATCH, S5_GROUPS, S5_STATE), 0.3),
        "state_ssm": nrm(ks[4], (D, DEC_BATCH, M_HEADS, M_HEADDIM, M_STATE), 0.1),
        "state_conv": nrm(ks[5], (D, DEC_BATCH, M_CONV - 1, M_CONV_DIM), 1.0),
        "c_prompt": nrm(ks[6], (BATCH, D_MODEL), 1.0),
        "c_sample": nrm(ks[7], (DEC_BATCH, D_MODEL), 1.0),
        "w_ada": nrm(ks[8], (D, D_MODEL, 6 * D_MODEL), 0.5 * D_MODEL ** -0.5),
        "b_ada": nrm(ks[9], (D, 6 * D_MODEL), 0.01),
        "norm_pre_mix": 1.0 + nrm(ks[10], (D, D_MODEL), 0.01),
        "norm_post_mix": 1.0 + nrm(ks[11], (D, D_MODEL), 0.01),
        "norm_pre_ffn": 1.0 + nrm(ks[12], (D, D_MODEL), 0.01),
        "norm_post_ffn": 1.0 + nrm(ks[13], (D, D_MODEL), 0.01),
        "w_in": nrm(ks[14], (D, D_MODEL, IN_COLS), D_MODEL ** -0.5),
        "s5_lam_re": -0.5 + nrm(ks[15], (D, S5_GROUPS, S5_STATE), 0.01),
        "s5_lam_im": math.pi * n_idx + nrm(ks[16], (D, S5_GROUPS, S5_STATE), 0.01),
        "s5_log_dt": jax.random.uniform(ks[17], (D, S5_GROUPS), f32, math.log(S5_DT_MIN), math.log(S5_DT_MAX)),
        "s5_b_re": nrm(ks[18], (D, S5_GROUPS, S5_STATE, S5_GROUP), (2 * S5_GROUP) ** -0.5),
        "s5_b_im": nrm(ks[19], (D, S5_GROUPS, S5_STATE, S5_GROUP), (2 * S5_GROUP) ** -0.5),
        "s5_c_re": nrm(ks[20], (D, S5_GROUPS, S5_GROUP, S5_STATE), (2 * S5_STATE) ** -0.5),
        "s5_c_im": nrm(ks[21], (D, S5_GROUPS, S5_GROUP, S5_STATE), (2 * S5_STATE) ** -0.5),
        "s5_d": nrm(ks[22], (D, S5_WIDTH), 1.0),
        "s5_w_glu": nrm(ks[23], (D, S5_WIDTH, S5_WIDTH), S5_WIDTH ** -0.5),
        "s5_b_glu": nrm(ks[24], (D, S5_WIDTH), 0.01),
        "m_conv_w": nrm(ks[25], (D, M_CONV, M_CONV_DIM), M_CONV ** -0.5),
        "m_conv_b": nrm(ks[26], (D, M_CONV_DIM), 0.01),
        "m_dt_bias": dt_m + jnp.log(-jnp.expm1(-dt_m)),
        "m_a_log": jnp.log(jax.random.uniform(ks[27], (D, M_HEADS), f32, 1.0, 16.0)),
        "m_d": 1.0 + nrm(ks[28], (D, M_HEADS), 0.1),
        "m_norm": 1.0 + nrm(ks[29], (D, M_INNER), 0.01),
        "w_branch_s5": nrm(ks[31], (D, S5_WIDTH, D_MODEL), S5_WIDTH ** -0.5),
        "w_branch_ssd": nrm(ks[32], (D, M_INNER, D_MODEL), M_INNER ** -0.5),
        "w_out": nrm(ks[33], (D, D_MODEL, D_MODEL), D_MODEL ** -0.5),
        "w_ffn_in": nrm(ks[34], (D, D_MODEL, 2 * D_FF), D_MODEL ** -0.5),
        "w_ffn_out": nrm(ks[35], (D, D_FF, D_MODEL), D_FF ** -0.5),
    }


def reference(x_prompt, x_sample, state_s5_re, state_s5_im, state_ssm, state_conv, c_prompt, c_sample,
              w_ada, b_ada, norm_pre_mix, norm_post_mix, norm_pre_ffn, norm_post_ffn, w_in,
              s5_lam_re, s5_lam_im, s5_log_dt, s5_b_re, s5_b_im, s5_c_re, s5_c_im, s5_d, s5_w_glu, s5_b_glu,
              m_conv_w, m_conv_b, m_dt_bias, m_a_log, m_d, m_norm,
              w_branch_s5, w_branch_ssd, w_out, w_ffn_in, w_ffn_out):
    bp = x_prompt.shape[0]
    dt_ = x_prompt.dtype
    xp, xs = x_prompt, x_sample
    p_re, p_im, p_ssm, p_conv = [], [], [], []
    s_re, s_im, s_ssm, s_conv = [], [], [], []
    for l in range(DEPTH):
        p = {
            "w_ada": w_ada[l], "b_ada": b_ada[l],
            "norm_pre_mix": norm_pre_mix[l], "norm_post_mix": norm_post_mix[l],
            "norm_pre_ffn": norm_pre_ffn[l], "norm_post_ffn": norm_post_ffn[l],
            "w_in": w_in[l],
            "s5_lam_re": s5_lam_re[l], "s5_lam_im": s5_lam_im[l], "s5_log_dt": s5_log_dt[l],
            "s5_b_re": s5_b_re[l], "s5_b_im": s5_b_im[l], "s5_c_re": s5_c_re[l], "s5_c_im": s5_c_im[l],
            "s5_d": s5_d[l], "s5_w_glu": s5_w_glu[l], "s5_b_glu": s5_b_glu[l],
            "m_conv_w": m_conv_w[l], "m_conv_b": m_conv_b[l], "m_dt_bias": m_dt_bias[l],
            "m_a_log": m_a_log[l], "m_d": m_d[l], "m_norm": m_norm[l],
            "w_branch_s5": w_branch_s5[l], "w_branch_ssd": w_branch_ssd[l], "w_out": w_out[l],
            "w_ffn_in": w_ffn_in[l], "w_ffn_out": w_ffn_out[l],
        }
        xp, a1, a2, a3, a4 = _layer(
            xp, c_prompt,
            jnp.zeros((bp, S5_GROUPS, S5_STATE), dt_), jnp.zeros((bp, S5_GROUPS, S5_STATE), dt_),
            jnp.zeros((bp, M_HEADS, M_HEADDIM, M_STATE), dt_), jnp.zeros((bp, M_CONV - 1, M_CONV_DIM), dt_), p)
        p_re.append(a1); p_im.append(a2); p_ssm.append(a3); p_conv.append(a4)
        xs, b1, b2, b3, b4 = _layer(xs, c_sample, state_s5_re[l], state_s5_im[l], state_ssm[l], state_conv[l], p)
        s_re.append(b1); s_im.append(b2); s_ssm.append(b3); s_conv.append(b4)
    y_prompt = xp
    y_sample = xs
    s5_re_prompt = jnp.stack(p_re, 0)
    s5_im_prompt = jnp.stack(p_im, 0)
    ssm_prompt = jnp.stack(p_ssm, 0)
    conv_prompt = jnp.stack(p_conv, 0)
    s5_re_sample = jnp.stack(s_re, 0)
    s5_im_sample = jnp.stack(s_im, 0)
    ssm_sample = jnp.stack(s_ssm, 0)
    conv_sample = jnp.stack(s_conv, 0)
    return (y_prompt, y_sample, s5_re_prompt, s5_im_prompt, ssm_prompt, conv_prompt,
            s5_re_sample, s5_im_sample, ssm_sample, conv_sample)
```

```cpp
#include <hip/hip_runtime.h>
#include <cstdio>
#include <cstdint>
namespace pg8 {
#define PG8_LAS __attribute__((address_space(3)))
typedef unsigned short bf16_t;
typedef short bf16x8 __attribute__((ext_vector_type(8)));
typedef float f32x4 __attribute__((ext_vector_type(4)));
typedef unsigned u32x4 __attribute__((ext_vector_type(4)));
constexpr int BM = 256, BK = 64, HALF = 128, HTB = HALF * BK * 2  , STAGE_BYTES = 8 * HTB, NXCD = 8, WGM = 8;

__host__ __device__ __forceinline__ int lds_byte(int r, int c) { const int st = (r >> 4) * 2 + (c >> 5), rr = r & 15, cc = c & 31, ob = rr * 64 + cc * 2; return st * 1024 + (ob ^ (((ob >> 9) & 1) << 5)); }
__host__ __device__ __forceinline__ void stage_rc(int b, int& R, int& C) { const int st = b / 1024, sb = b % 1024, swz = sb ^ (((sb >> 9) & 1) << 5); R = (st >> 1) * 16 + swz / 64; C = (st & 1) * 32 + (swz % 64) / 2; }
__host__ __device__ __forceinline__ int perm32(int rho) { const int n = rho >> 4, i = rho & 15; return 8 * (i >> 2) + 4 * n + (i & 3); }

struct Unit { int pm, pn; };
struct Gemm { const bf16_t* A; const bf16_t* Bt; int M, N, K; };

struct StaticOrder {
    int nM, nN, nwg, G, c;
    __host__ __device__ void init(int M, int N, int G_, int c_) { nM = M / BM; nN = N / BM; nwg = nM * nN; G = G_; c = c_; }
    __host__ __device__ bool next(int i, Unit& u) const {
        const long L = (long)i * G + c; if (L >= nwg) return false;
        int wgid = (int)L; { const int q = nwg / NXCD, r = nwg % NXCD, xcd = wgid % NXCD, off = wgid / NXCD; wgid = (xcd < r ? xcd * (q + 1) : r * (q + 1) + (xcd - r) * q) + off; }
        const int nig = WGM * nN, gid = wgid / nig, fm = gid * WGM, gsz = (nM - fm) < WGM ? (nM - fm) : WGM;
        u.pm = fm + ((wgid % nig) % gsz); u.pn = (wgid % nig) / gsz; return true;
    }
    __device__ __forceinline__ void a_ready(const Unit&) const {}
    __device__ __forceinline__ void done(const Unit&) const {}
};

__device__ __forceinline__ unsigned cvt_pk_bf16(float lo, float hi) { unsigned r; asm volatile("v_cvt_pk_bf16_f32 %0, %1, %2" : "=v"(r) : "v"(lo), "v"(hi)); return r; }
typedef float f32x2 __attribute__((ext_vector_type(2)));
__device__ __forceinline__ f32x2 gelu_pk(f32x2 v) {
    const f32x2 av = __builtin_elementwise_abs(v), d = av * 0.2316418882f + 1.0f;
    f32x2 t; t.x = __builtin_amdgcn_rcpf(d.x); t.y = __builtin_amdgcn_rcpf(d.y);
    f32x2 q = t * 0.5307027145f + (-0.7265760135f); q = q * t + 0.7107068705f; q = q * t + (-0.142248368f); q = q * t + 0.127414796f; q = q * t;
    const f32x2 s = (v * v) * (-0.72134752044f);
    f32x2 e; e.x = __builtin_amdgcn_exp2f(s.x); e.y = __builtin_amdgcn_exp2f(s.y);
    const f32x2 m = v * (q * e), r = v - m;
    f32x2 o; o.x = v.x < 0.f ? m.x : r.x; o.y = v.y < 0.f ? m.y : r.y; return o;
}

template <int ACT  > struct EpiBf16 {
    static constexpr bool PERM = true, AFTER_DRAIN = false, HAS_MID = false; static_assert(ACT == 0 || ACT == 1, "EpiBf16: ACT is 0 (none) or 1 (gelu_pk)");
    bf16_t* O; int ldc; const float* bias; int split_cols; size_t split_stride; float scale0;
    __device__ __forceinline__ void operator()(const f32x4 (&acc)[2][2][4][2], const Unit& u, int wr, int wc, int fr, int fq) const {
        const int row0 = u.pm * BM + wr * 64 + fr; int colt = u.pn * BM; bf16_t* base = O;
        float sc = 1.f; if (split_cols) { const int t = colt / split_cols; base += (size_t)t * split_stride; colt -= t * split_cols; if (t == 0) sc = scale0; }
        const int col0 = colt + wc * 32 + 8 * fq, bcol0 = u.pn * BM + wc * 32 + 8 * fq;
        f32x4 bv[2][2];
#pragma unroll
        for (int bj = 0; bj < 2; ++bj)
#pragma unroll
            for (int n = 0; n < 2; ++n) bv[bj][n] = bias ? *(const f32x4*)(bias + bcol0 + bj * HALF + 4 * n) : (f32x4){0.f, 0.f, 0.f, 0.f};
#pragma unroll
        for (int ai = 0; ai < 2; ++ai)
#pragma unroll
            for (int m = 0; m < 4; ++m) { bf16_t* rowp = base + (size_t)(row0 + ai * HALF + m * 16) * ldc + col0;
#pragma unroll
                for (int bj = 0; bj < 2; ++bj) { f32x4 v0 = acc[ai][bj][m][0] + bv[bj][0], v1 = acc[ai][bj][m][1] + bv[bj][1];
                    if (ACT == 1) { f32x2 a = gelu_pk((f32x2){v0[0], v0[1]}), b = gelu_pk((f32x2){v0[2], v0[3]}), c = gelu_pk((f32x2){v1[0], v1[1]}), d = gelu_pk((f32x2){v1[2], v1[3]});
                        v0 = (f32x4){a.x, a.y, b.x, b.y}; v1 = (f32x4){c.x, c.y, d.x, d.y}; }
                    v0 = v0 * sc; v1 = v1 * sc; u32x4 w; w.x = cvt_pk_bf16(v0[0], v0[1]); w.y = cvt_pk_bf16(v0[2], v0[3]); w.z = cvt_pk_bf16(v1[0], v1[1]); w.w = cvt_pk_bf16(v1[2], v1[3]);
                    *(u32x4*)(rowp + bj * HALF) = w; } }
    }
};
template <class Epi, class Sched, bool ALIGN_EPI = false, bool SP2 = false>
__device__ __forceinline__ void gemm_phase(PG8_LAS unsigned char* lds, const Gemm g, const Sched& S, const Epi& E) {
    int tid_ = threadIdx.x; asm volatile("" : "+v"(tid_));
    const int tid = tid_, wid = __builtin_amdgcn_readfirstlane(tid >> 6), lane = tid & 63, wr = wid >> 2, wc = wid & 3, fr = lane & 15, fq = lane >> 4;
    const int K = g.K, nt = K / BK;
    unsigned voffA[2], voffB[2];
#pragma unroll
    for (int i = 0; i < 2; ++i) { int R, C; stage_rc(tid * 16 + i * 8192, R, C); const int Rb = Epi::PERM ? ((R & ~31) + perm32(R & 31)) : R;
        voffA[i] = (unsigned)(R * K + C) * 2u; voffB[i] = (unsigned)(Rb * K + C) * 2u; }
    const size_t kstep = (size_t)(BK * 2);
    const size_t hstep = (size_t)HALF * K * 2;
    const size_t tstep = 2 * hstep;
    const unsigned ldsw = (unsigned)wid * 1024u;
    const int aoff = lds_byte(wr * 64 + fr, fq * 8), boff = lds_byte(wc * 32 + fr, fq * 8);
#define PG8_SA(b, h) (((b) * 2 + (h)) * HTB)
#define PG8_SB(b, h) ((4 + (b) * 2 + (h)) * HTB)
#define PG8_STAGE(bufoff, gbase, voff) do { _Pragma("unroll") for (int _i = 0; _i < 2; ++_i) \
        __builtin_amdgcn_global_load_lds((const unsigned*)((const char*)(gbase) + (voff)[_i]), (PG8_LAS unsigned*)(lds + (bufoff) + ldsw + _i * 8192), 16, 0, 0); } while (0)
#define PG8_LDA(dst, b, h) do { _Pragma("unroll") for (int m = 0; m < 4; ++m) _Pragma("unroll") for (int k = 0; k < 2; ++k) dst[m][k] = *(const PG8_LAS bf16x8*)(lds + PG8_SA(b, h) + aoff + m * 2048 + k * 1024); } while (0)
#define PG8_LDB(dst, b, h) do { _Pragma("unroll") for (int n = 0; n < 2; ++n) _Pragma("unroll") for (int k = 0; k < 2; ++k) dst[n][k] = *(const PG8_LAS bf16x8*)(lds + PG8_SB(b, h) + boff + n * 2048 + k * 1024); } while (0)
#define PG8_MMA(ai, bj, At, Bt) do { __builtin_amdgcn_s_setprio(1); _Pragma("unroll") for (int m = 0; m < 4; ++m) _Pragma("unroll") for (int n = 0; n < 2; ++n) _Pragma("unroll") for (int k = 0; k < 2; ++k) \
        acc[ai][bj][m][n] = __builtin_amdgcn_mfma_f32_16x16x32_bf16(Bt[n][k], At[m][k], acc[ai][bj][m][n], 0, 0, 0); __builtin_amdgcn_s_setprio(0); } while (0)
#define PG8_WAIT_V(n) asm volatile("s_waitcnt vmcnt(" #n ")" ::: "memory")
#define PG8_WAIT_L(n) asm volatile("s_waitcnt lgkmcnt(" #n ")" ::: "memory")
#define PG8_BAR __builtin_amdgcn_s_barrier()
#define PG8_SCHED __builtin_amdgcn_sched_barrier(0)
    Unit cur, nxt; int ui = 0;
    if (!S.next(0, cur)) return;
    f32x4 acc[2][2][4][2];
#pragma unroll
    for (int a = 0; a < 2; ++a)
#pragma unroll
        for (int b = 0; b < 2; ++b)
#pragma unroll
            for (int m = 0; m < 4; ++m)
#pragma unroll
                for (int n = 0; n < 2; ++n) acc[a][b][m][n] = (f32x4){0.f, 0.f, 0.f, 0.f};
    bf16x8 At[4][2], B0[2][2], B1[2][2];
    const char* cA = (const char*)g.A + (size_t)cur.pm * tstep; const char* cB = (const char*)g.Bt + (size_t)cur.pn * tstep;
    S.a_ready(cur);
    if constexpr (SP2) {
        PG8_STAGE(PG8_SB(0, 0), cB, voffB); PG8_STAGE(PG8_SB(0, 1), cB + hstep, voffB); PG8_STAGE(PG8_SA(0, 0), cA, voffA); PG8_STAGE(PG8_SA(0, 1), cA + hstep, voffA);
        if (wr == 1) PG8_BAR;
        PG8_WAIT_V(2); PG8_BAR;
        PG8_STAGE(PG8_SB(1, 0), cB + kstep, voffB); PG8_STAGE(PG8_SA(1, 0), cA + kstep, voffA); PG8_STAGE(PG8_SB(1, 1), cB + hstep + kstep, voffB);
        PG8_WAIT_V(6); PG8_BAR;
    } else {
        PG8_STAGE(PG8_SB(0, 0), cB, voffB); PG8_STAGE(PG8_SA(0, 0), cA, voffA); PG8_STAGE(PG8_SB(0, 1), cB + hstep, voffB); PG8_STAGE(PG8_SA(0, 1), cA + hstep, voffA);
        if (wr == 1) PG8_BAR;
        PG8_WAIT_V(4); PG8_BAR;
        PG8_STAGE(PG8_SB(1, 0), cB + kstep, voffB); PG8_STAGE(PG8_SA(1, 0), cA + kstep, voffA); PG8_STAGE(PG8_SB(1, 1), cB + hstep + kstep, voffB);
        PG8_WAIT_V(6); PG8_BAR;
    }
    for (;;) {
        const bool has_next = S.next(ui + 1, nxt);
        const char* nA = has_next ? (const char*)g.A + (size_t)nxt.pm * tstep : cA; const char* nB = has_next ? (const char*)g.Bt + (size_t)nxt.pn * tstep : cB;
        for (int seg = 0; seg < (Epi::HAS_MID ? 2 : 1); ++seg) {
        int tb = 0, te = nt; if constexpr (Epi::HAS_MID) { tb = seg ? E.mid_t : 0; te = seg ? nt : E.mid_t; }
        for (int t = tb; t < te; t += 2) {
            const bool last = (t == nt - 2);
            const char* a1 = cA + (size_t)(t + 1) * kstep;
            const char* a2 = last ? nA : cA + (size_t)(t + 2) * kstep; const char* b2 = last ? nB : cB + (size_t)(t + 2) * kstep;
            const char* a3 = a2 + kstep; const char* b3 = b2 + kstep;
            if (last && has_next) S.a_ready(nxt);
            if constexpr (SP2) {
            PG8_LDB(B0, 0, 0); PG8_LDB(B1, 0, 1); PG8_SCHED; PG8_LDA(At, 0, 0); PG8_STAGE(PG8_SA(1, 1), a1 + hstep, voffA);
            PG8_WAIT_V(8); PG8_WAIT_L(0); PG8_BAR; PG8_MMA(0, 0, At, B0); PG8_MMA(0, 1, At, B1); PG8_BAR; PG8_SCHED;
            PG8_LDA(At, 0, 1); PG8_STAGE(PG8_SB(0, 0), b2, voffB); PG8_STAGE(PG8_SB(0, 1), b2 + hstep, voffB); PG8_STAGE(PG8_SA(0, 0), a2, voffA);
            PG8_WAIT_V(8); PG8_WAIT_L(0); PG8_BAR; PG8_MMA(1, 0, At, B0); PG8_MMA(1, 1, At, B1); PG8_BAR; PG8_SCHED;
            PG8_LDB(B0, 1, 0); PG8_LDB(B1, 1, 1); PG8_SCHED; PG8_LDA(At, 1, 0); PG8_STAGE(PG8_SA(0, 1), a2 + hstep, voffA);
            PG8_WAIT_V(8); PG8_WAIT_L(0); PG8_BAR; PG8_MMA(0, 0, At, B0); PG8_MMA(0, 1, At, B1); PG8_BAR; PG8_SCHED;
            PG8_LDA(At, 1, 1); PG8_STAGE(PG8_SB(1, 0), b3, voffB); PG8_STAGE(PG8_SB(1, 1), b3 + hstep, voffB); PG8_STAGE(PG8_SA(1, 0), a3, voffA);
            PG8_WAIT_V(8); PG8_WAIT_L(0); PG8_BAR; PG8_MMA(1, 0, At, B0); PG8_MMA(1, 1, At, B1); PG8_BAR; PG8_SCHED;
            } else {
            PG8_LDB(B0, 0, 0); PG8_SCHED; PG8_LDA(At, 0, 0); PG8_STAGE(PG8_SA(1, 1), a1 + hstep, voffA);
            PG8_WAIT_L(8); PG8_BAR; PG8_WAIT_L(0); PG8_MMA(0, 0, At, B0); PG8_BAR; PG8_SCHED;
            PG8_LDB(B1, 0, 1); PG8_STAGE(PG8_SB(0, 0), b2, voffB);
            PG8_BAR; PG8_WAIT_L(0); PG8_MMA(0, 1, At, B1); PG8_BAR;
            PG8_LDA(At, 0, 1); PG8_STAGE(PG8_SA(0, 0), a2, voffA);
            PG8_BAR; PG8_WAIT_L(0); PG8_MMA(1, 0, At, B0); PG8_BAR; PG8_SCHED;
            PG8_STAGE(PG8_SB(0, 1), b2 + hstep, voffB);
            PG8_WAIT_V(6); PG8_BAR; PG8_MMA(1, 1, At, B1); PG8_BAR;
            PG8_LDB(B0, 1, 0); PG8_SCHED; PG8_LDA(At, 1, 0); PG8_STAGE(PG8_SA(0, 1), a2 + hstep, voffA);
            PG8_WAIT_L(8); PG8_BAR; PG8_WAIT_L(0); PG8_MMA(0, 0, At, B0); PG8_BAR; PG8_SCHED;
            PG8_LDB(B1, 1, 1); PG8_STAGE(PG8_SB(1, 0), b3, voffB);
            PG8_BAR; PG8_WAIT_L(0); PG8_MMA(0, 1, At, B1); PG8_BAR;
            PG8_LDA(At, 1, 1); PG8_STAGE(PG8_SA(1, 0), a3, voffA);
            PG8_BAR; PG8_WAIT_L(0); PG8_MMA(1, 0, At, B0); PG8_BAR; PG8_SCHED;
            PG8_STAGE(PG8_SB(1, 1), b3 + hstep, voffB);
            PG8_WAIT_V(6); PG8_BAR; PG8_MMA(1, 1, At, B1); PG8_BAR;
            }
        }
        if constexpr (Epi::HAS_MID) { if (seg == 0) E.mid(acc, cur, wr, wc, fr, fq); }
        }
        if constexpr (ALIGN_EPI) { if (wr == 0) PG8_BAR; }
        if constexpr (!Epi::AFTER_DRAIN) { E(acc, cur, wr, wc, fr, fq); S.done(cur); }
        if (!has_next) break;
#pragma unroll
        for (int a = 0; a < 2; ++a)
#pragma unroll
            for (int b = 0; b < 2; ++b)
#pragma unroll
                for (int m = 0; m < 4; ++m)
#pragma unroll
                    for (int n = 0; n < 2; ++n) acc[a][b][m][n] = (f32x4){0.f, 0.f, 0.f, 0.f};
        cur = nxt; cA = nA; cB = nB; ++ui;
        if constexpr (ALIGN_EPI) { if (wr == 1) PG8_BAR; }
    }
    PG8_WAIT_V(0);
    if constexpr (!ALIGN_EPI) { if (wr == 0) PG8_BAR; }
    PG8_BAR;
    if constexpr (Epi::AFTER_DRAIN) { E.fused(acc, cur, wr, wc, fr, fq, lds, wid, lane); S.done(cur); }
#undef PG8_SA
#undef PG8_SB
#undef PG8_STAGE
#undef PG8_LDA
#undef PG8_LDB
#undef PG8_MMA
#undef PG8_WAIT_V
#undef PG8_WAIT_L
#undef PG8_BAR
#undef PG8_SCHED
}
}

#define GAS __attribute__((address_space(1)))
#define LAS __attribute__((address_space(3)))
typedef unsigned short bf16;
typedef unsigned v4u __attribute__((ext_vector_type(4)));
typedef unsigned v2u __attribute__((ext_vector_type(2)));
typedef float f32x4 __attribute__((ext_vector_type(4)));
typedef short bf16x8 __attribute__((ext_vector_type(8)));
typedef GAS unsigned gu32;
#define RLX_AGENT __ATOMIC_RELAXED, __HIP_MEMORY_SCOPE_AGENT
#define LDS_WAIT() asm volatile("s_waitcnt lgkmcnt(0)" ::: "memory")
#define VM_WAIT() asm volatile("s_waitcnt vmcnt(0)" ::: "memory")
__device__ __forceinline__ unsigned f2bf(float f) { unsigned u = __builtin_bit_cast(unsigned, f); return (u + 0x7fffu + ((u >> 16) & 1u)) >> 16; }
__device__ __forceinline__ unsigned pk2(float lo, float hi) { return pg8::cvt_pk_bf16(lo, hi); }
__device__ __forceinline__ float bflo(unsigned w) { return __uint_as_float(w << 16); }
__device__ __forceinline__ float bfhi(unsigned w) { return __uint_as_float(w & 0xffff0000u); }
__device__ __forceinline__ float bf2f(bf16 h) { return __uint_as_float((unsigned)h << 16); }
__device__ __forceinline__ float sigmoidf_(float x) { return 1.0f / (1.0f + __expf(-x)); }
__device__ __forceinline__ float siluf_(float x) { return x / (1.0f + __expf(-x)); }
__device__ __forceinline__ float softplusf_(float x) { return fmaxf(x, 0.f) + log1pf(__expf(-fabsf(x))); }
__device__ __forceinline__ float gelu_tanh(float y) { const float z = 0.7978845608028654f * (y + 0.044715f * y * y * y); const float t = 1.0f - 2.0f / (1.0f + __expf(2.0f * z)); return 0.5f * y * (1.0f + t); }
__device__ __forceinline__ float wave_sum(float v) {
#pragma unroll
    for (int o = 1; o < 64; o <<= 1) v += __shfl_xor(v, o);
    return v;
}
#define XB_TMO      128
#define XB_XCNT(j)  (256  + 64 * (j))
#define XB_XSUB(j)  (1280 + 64 * (j))
#define XB_XGEN(j)  (2304 + 64 * (j))
#define XB_TOP      3328
#define XB_TOPGEN   3392
#define XCD_BAR_WORDS 3456
#define XB_SPIN_CAP (1u << 18)

__device__ __forceinline__ unsigned xb_ld(unsigned* p)              { return __hip_atomic_load(p, __ATOMIC_RELAXED, __HIP_MEMORY_SCOPE_AGENT); }
__device__ __forceinline__ unsigned xb_add(unsigned* p, unsigned v) { return __hip_atomic_fetch_add(p, v, __ATOMIC_RELAXED, __HIP_MEMORY_SCOPE_AGENT); }
__device__ __forceinline__ unsigned xb_xcc_id() { return (unsigned)__builtin_amdgcn_s_getreg((3 << 11) | 20) & 0xFu; }
#define XB_SPIN(cond, bar) do { unsigned _sp = 0; while (cond) { __builtin_amdgcn_s_sleep(1); \
    if ((++_sp & 255u) == 0u) { if (xb_ld(&(bar)[XB_TMO])) break; if (_sp > XB_SPIN_CAP) { atomicAdd(&(bar)[XB_TMO], 1u); break; } } } } while (0)

struct XcdBarrier {
    unsigned* bar; unsigned x;
    volatile LAS unsigned* st;
};

__device__ __forceinline__ XcdBarrier xcd_barrier_post(unsigned* bar, volatile LAS unsigned* st) {
    XcdBarrier b; b.bar = bar; b.x = xb_xcc_id(); b.st = st;
    if (threadIdx.x == 0) (void)xb_add(&bar[XB_XCNT(b.x)], 1u);
    return b;
}
__device__ __forceinline__ void xcd_barrier_complete(unsigned* bar, unsigned x, unsigned& nloc, unsigned& nx) {
    const unsigned G = gridDim.x * gridDim.y * gridDim.z;
    unsigned sum, cnt, mine, sp = 0u;
    for (;;) {
        sum = 0u; cnt = 0u; mine = 0u;
#pragma unroll
        for (unsigned j = 0; j < 16; ++j) { const unsigned c = xb_ld(&bar[XB_XCNT(j)]); sum += c; cnt += (c > 0u) ? 1u : 0u; mine = (j == x) ? c : mine; }
        if (sum == G) break;
        __builtin_amdgcn_s_sleep(1);
        if ((++sp & 255u) == 0u) { if (xb_ld(&bar[XB_TMO])) break; if (sp > XB_SPIN_CAP) { atomicAdd(&bar[XB_TMO], 1u); break; } }
    }
    nloc = mine > 0u ? mine : 1u; nx = cnt > 0u ? cnt : 1u;
}

__device__ __forceinline__ void xcd_barrier(const XcdBarrier& b) {
    asm volatile("s_waitcnt vmcnt(0)" ::: "memory");
    __syncthreads();
    if (threadIdx.x == 0) {
        unsigned* bar = b.bar;
        __builtin_amdgcn_s_waitcnt(0);
        unsigned nloc = b.st[0], nx = b.st[1];
        if (nloc == 0u) { xcd_barrier_complete(bar, b.x, nloc, nx); b.st[0] = nloc; b.st[1] = nx; }
        const unsigned old = xb_add(&bar[XB_XSUB(b.x)], 1u);
        const unsigned gen = old / nloc;
        if (old + 1u == (gen + 1u) * nloc) {
            __builtin_amdgcn_fence(__ATOMIC_RELEASE, "agent");
            asm volatile("s_waitcnt vmcnt(0)" ::: "memory");
            const unsigned og = xb_add(&bar[XB_TOP], 1u);
            const unsigned tg = og / nx;
            if (og + 1u == (tg + 1u) * nx) xb_add(&bar[XB_TOPGEN], 1u);
            else XB_SPIN(xb_ld(&bar[XB_TOPGEN]) == tg, bar);
            __builtin_amdgcn_fence(__ATOMIC_ACQUIRE, "agent");
            xb_add(&bar[XB_XGEN(b.x)], 1u);
            asm volatile("s_waitcnt vmcnt(0)" ::: "memory");
        } else {
            XB_SPIN(xb_ld(&bar[XB_XGEN(b.x)]) == gen, bar);
            __builtin_amdgcn_fence(__ATOMIC_ACQUIRE, "agent");
            asm volatile("s_waitcnt vmcnt(0)" ::: "memory");
        }
    }
    __syncthreads();
}

constexpr int NWAVES = 8;
#ifndef P_MOD
#define P_MOD 1
#endif
#ifndef P_TAB
#define P_TAB 1
#endif
#ifndef P_WCVT
#define P_WCVT 1
#endif
#ifndef P_NORM1
#define P_NORM1 1
#endif
#ifndef P_CONV
#define P_CONV 1
#endif
#ifndef P_S5S
#define P_S5S 1
#endif
#ifndef P_RS
#define P_RS 1
#endif
#ifndef P_P5B
#define P_P5B 1
#endif
#ifndef P_P8
#define P_P8 1
#endif
#ifndef P_SSDP
#define P_SSDP 1
#endif
#ifndef P_S5P
#define P_S5P 1
#endif
#ifndef P_SSDS
#define P_SSDS 1
#endif
#ifndef P_G2
#define P_G2 1
#endif
#ifndef P_G6
#define P_G6 1
#endif
#ifndef P_G7
#define P_G7 1
#endif
#ifndef P_G8
#define P_G8 1
#endif
#ifndef P_G9
#define P_G9 1
#endif
#ifndef P_G11
#define P_G11 1
#endif
#ifndef P_G12
#define P_G12 1
#endif
#ifndef REP_SSDP
#define REP_SSDP 1
#endif
#ifndef REP_SSDS
#define REP_SSDS 1
#endif
#ifndef REP_S5P
#define REP_S5P 1
#endif
#ifndef REP_GEMM
#define REP_GEMM 1
#endif
#ifndef MK_ONE_LAUNCH
#define MK_ONE_LAUNCH 1
#endif
constexpr int DM = 1024, NBATCH = 8, SEQ = 2048, MP = NBATCH * SEQ, MS = 128, MT = MP + MS, MPAD = 16640, NMOD = NBATCH + MS;
constexpr int G5 = 64, N5 = 64, H5 = 16;
constexpr int MIN = 2048, HD = 64, NH = 32, NG = 4, NST = 128, CDIM = 3072;
constexpr int DFF = 2816, NPROJ = 8448;
constexpr float EPS = 1e-6f;
enum { I_XP = 0, I_XS, I_S5RE, I_S5IM, I_SSM, I_CONV, I_CP, I_CS, I_WADA, I_BADA, I_NPM, I_NPOM, I_NPF, I_NPOF, I_WIN, I_LRE, I_LIM, I_LDT, I_BRE, I_BIM, I_CRE, I_CIM, I_S5D,
       I_WGLU, I_BGLU, I_CW, I_CB, I_DTB, I_ALOG, I_MD, I_MNORM, I_WBS5, I_WBSSD, I_WOUT, I_WFI, I_WFO, N_IN };
constexpr size_t O_YP = 0, O_YS = O_YP + (size_t)MP * DM, O_S5RP = O_YS + (size_t)MS * DM, O_S5IP = O_S5RP + NBATCH * G5 * N5, O_SSMP = O_S5IP + NBATCH * G5 * N5,
                 O_CONVP = O_SSMP + (size_t)NBATCH * NH * HD * NST, O_S5RS = O_CONVP + NBATCH * 3 * CDIM, O_S5IS = O_S5RS + MS * G5 * N5, O_SSMS = O_S5IS + MS * G5 * N5,
                 O_CONVS = O_SSMS + (size_t)MS * NH * HD * NST, O_END = O_CONVS + (size_t)MS * 3 * CDIM;

constexpr size_t MiB = 1u << 20;
constexpr size_t WS_CTL = 0, CTL_ZERO_BYTES = 1 * MiB;
constexpr size_t WS_MOD = 1 * MiB;
constexpr size_t WS_DT = 5 * MiB;
constexpr size_t WS_RS = 8 * MiB;
constexpr size_t WS_ABAR = 9 * MiB;
constexpr size_t WS_BBAR = 9 * MiB + 64 * 1024;
constexpr size_t WS_WIN = 16 * MiB, WS_WGLU = 33 * MiB, WS_WBR = 35 * MiB  , WS_WOUT = 41 * MiB, WS_WFI = 43 * MiB, WS_WFO = 54 * MiB;
constexpr size_t WS_H = 64 * MiB;
constexpr size_t WS_GA = 97 * MiB, WS_GB = 130 * MiB;
constexpr size_t WS_U = 163 * MiB;
constexpr size_t WS_Z = 196 * MiB;
constexpr size_t WS_XBC = 261 * MiB;
constexpr size_t WS_ACT = 359 * MiB;
constexpr size_t WS_YA = 457 * MiB;
constexpr size_t WS_GY = 261 * MiB;
constexpr size_t WS_SSQ = 10 * MiB;
constexpr size_t WS_MERGED = 359 * MiB;
constexpr size_t WS_MIX = 392 * MiB;
constexpr size_t WS_X1 = 196 * MiB;
constexpr size_t WS_FA = 261 * MiB;
constexpr size_t WS_FO = 359 * MiB;
constexpr size_t WS_A32 = 9 * MiB + 32 * 1024;
constexpr size_t WS_KT = 490 * MiB;
constexpr size_t WS_SMF = 492 * MiB;
constexpr size_t WS_OMF = 500 * MiB;
constexpr size_t WS_END = 508 * MiB;
constexpr int CW_BAR = 4096;
constexpr int LDS_BYTES = 147456;
constexpr int MISC_OFF = LDS_BYTES - 128;

struct Args { const float* in[N_IN]; float* out; unsigned char* ws; int ph_lo, ph_hi; };

namespace pg8 {
struct EpiProj {
    static constexpr bool PERM = true, AFTER_DRAIN = false, HAS_MID = false;
    bf16_t *U, *Z, *XBC, *GA, *GB; float* DT; const float* dt_bias;
    __device__ __forceinline__ void operator()(const f32x4 (&acc)[2][2][4][2], const Unit& u, int wr, int wc, int fr, int fq) const {
        const int row0 = u.pm * BM + wr * 64 + fr, pn = u.pn;
        if (pn < 32) {
            bf16_t* base; int ld, colt; bool sg = false;
            if (pn < 4) { base = U; ld = 1024; colt = pn * 256; } else if (pn < 12) { base = Z; ld = 2048; colt = (pn - 4) * 256; } else if (pn < 24) { base = XBC; ld = 3072; colt = (pn - 12) * 256; }
            else if (pn < 28) { base = GA; ld = 1024; colt = (pn - 24) * 256; sg = true; } else { base = GB; ld = 1024; colt = (pn - 28) * 256; sg = true; }
            const int col0 = colt + wc * 32 + 8 * fq;
#pragma unroll
            for (int ai = 0; ai < 2; ++ai)
#pragma unroll
                for (int m = 0; m < 4; ++m) { bf16_t* rowp = base + (size_t)(row0 + ai * HALF + m * 16) * ld + col0;
#pragma unroll
                    for (int bj = 0; bj < 2; ++bj) { f32x4 v0 = acc[ai][bj][m][0], v1 = acc[ai][bj][m][1];
                        if (sg) {
#pragma unroll
                            for (int e = 0; e < 4; ++e) { v0[e] = sigmoidf_(v0[e]); v1[e] = sigmoidf_(v1[e]); } }
                        u32x4 w; w.x = cvt_pk_bf16(v0[0], v0[1]); w.y = cvt_pk_bf16(v0[2], v0[3]); w.z = cvt_pk_bf16(v1[0], v1[1]); w.w = cvt_pk_bf16(v1[2], v1[3]);
                        *(u32x4*)(rowp + bj * HALF) = w; } }
        } else if (wc == 0) {
            const int c0 = 8 * fq;
            const f32x4 b0 = *(const f32x4*)(dt_bias + c0), b1 = *(const f32x4*)(dt_bias + c0 + 4);
#pragma unroll
            for (int ai = 0; ai < 2; ++ai)
#pragma unroll
                for (int m = 0; m < 4; ++m) { float* rowp = DT + (size_t)(row0 + ai * HALF + m * 16) * 32 + c0; f32x4 v0 = acc[ai][0][m][0] + b0, v1 = acc[ai][0][m][1] + b1;
#pragma unroll
                    for (int e = 0; e < 4; ++e) { v0[e] = softplusf_(v0[e]); v1[e] = softplusf_(v1[e]); }
                    *(f32x4*)rowp = v0; *(f32x4*)(rowp + 4) = v1; }
        }
    }
};
template <int MODE> struct EpiGate {
    static constexpr bool PERM = true, AFTER_DRAIN = false, HAS_MID = false;
    bf16_t* O; const bf16_t* X; const bf16_t* Y; const float* bias; const float* rs; int ldo;
    __device__ __forceinline__ void chunk(int row, int col0, const float (&av)[8]) const {
        const size_t off = (size_t)row * 1024 + col0;
        const u32x4 xw = *(const u32x4*)(X + off);
        const float xv[8] = {bflo(xw.x), bfhi(xw.x), bflo(xw.y), bfhi(xw.y), bflo(xw.z), bfhi(xw.z), bflo(xw.w), bfhi(xw.w)}; float o[8];
        if (MODE == 0) { const f32x4 b0 = *(const f32x4*)(bias + col0), b1 = *(const f32x4*)(bias + col0 + 4); const float bv[8] = {b0[0], b0[1], b0[2], b0[3], b1[0], b1[1], b1[2], b1[3]};
#pragma unroll
            for (int e = 0; e < 8; ++e) o[e] = xv[e] * sigmoidf_(av[e] + bv[e]);
        } else if (MODE == 1) {
#pragma unroll
            for (int e = 0; e < 8; ++e) o[e] = xv[e] * av[e];
        } else { const float r = rs[row]; const u32x4 yw = *(const u32x4*)(Y + off);
            const float yv[8] = {bflo(yw.x), bfhi(yw.x), bflo(yw.y), bfhi(yw.y), bflo(yw.z), bfhi(yw.z), bflo(yw.w), bfhi(yw.w)};
#pragma unroll
            for (int e = 0; e < 8; ++e) o[e] = yv[e] + xv[e] * r * av[e]; }
        u32x4 w; w.x = cvt_pk_bf16(o[0], o[1]); w.y = cvt_pk_bf16(o[2], o[3]); w.z = cvt_pk_bf16(o[4], o[5]); w.w = cvt_pk_bf16(o[6], o[7]);
        *(u32x4*)(O + (size_t)row * ldo + col0) = w;
    }
    __device__ __forceinline__ void operator()(const f32x4 (&acc)[2][2][4][2], const Unit& u, int wr, int wc, int fr, int fq) const {
        const int row0 = u.pm * BM + wr * 64 + fr, col0 = u.pn * BM + wc * 32 + 8 * fq;
#pragma unroll
        for (int ai = 0; ai < 2; ++ai)
#pragma unroll
            for (int m = 0; m < 4; ++m)
#pragma unroll
                for (int bj = 0; bj < 2; ++bj) { const f32x4 a0 = acc[ai][bj][m][0], a1 = acc[ai][bj][m][1]; const float av[8] = {a0[0], a0[1], a0[2], a0[3], a1[0], a1[1], a1[2], a1[3]};
                    chunk(row0 + ai * HALF + m * 16, col0 + bj * HALF, av); }
    }
};
struct EpiF32 {
    static constexpr bool PERM = true, AFTER_DRAIN = false, HAS_MID = false;
    float* C;
    __device__ __forceinline__ void chunk(int row, int col0, const float (&av)[8]) const {
        float* p = C + (size_t)row * 1024 + col0; *(f32x4*)p = (f32x4){av[0], av[1], av[2], av[3]}; *(f32x4*)(p + 4) = (f32x4){av[4], av[5], av[6], av[7]}; }
    __device__ __forceinline__ void operator()(const f32x4 (&acc)[2][2][4][2], const Unit& u, int wr, int wc, int fr, int fq) const {
        const int row0 = u.pm * BM + wr * 64 + fr, col0 = u.pn * BM + wc * 32 + 8 * fq;
#pragma unroll
        for (int ai = 0; ai < 2; ++ai)
#pragma unroll
            for (int m = 0; m < 4; ++m)
#pragma unroll
                for (int bj = 0; bj < 2; ++bj) { const f32x4 a0 = acc[ai][bj][m][0], a1 = acc[ai][bj][m][1]; const float av[8] = {a0[0], a0[1], a0[2], a0[3], a1[0], a1[1], a1[2], a1[3]};
                    chunk(row0 + ai * HALF + m * 16, col0 + bj * HALF, av); }
    }
};
struct EpiMerge {
    static constexpr bool PERM = true, AFTER_DRAIN = false, HAS_MID = true;
    bf16_t* O; const bf16_t* GA; const bf16_t* GB; const PG8_LAS float* rsl; int mid_t;
    __device__ __forceinline__ void mid(f32x4 (&acc)[2][2][4][2], const Unit& u, int wr, int wc, int fr, int fq) const {
        int lr0 = wr * 64 + fr, col0 = u.pn * BM + wc * 32 + 8 * fq; asm volatile("" : "+v"(lr0), "+v"(col0));
#pragma unroll
        for (int ai = 0; ai < 2; ++ai)
#pragma unroll
            for (int m = 0; m < 4; ++m) { const int lr = lr0 + ai * HALF + m * 16; const float r = rsl[lr]; const size_t off = (size_t)(u.pm * BM + lr) * 1024 + col0;
#pragma unroll
                for (int bj = 0; bj < 2; ++bj) { const u32x4 aw = *(const u32x4*)(GA + off + bj * HALF), bw = *(const u32x4*)(GB + off + bj * HALF);
                    const float ga[8] = {bflo(aw.x), bfhi(aw.x), bflo(aw.y), bfhi(aw.y), bflo(aw.z), bfhi(aw.z), bflo(aw.w), bfhi(aw.w)};
                    const float gb[8] = {bflo(bw.x), bfhi(bw.x), bflo(bw.y), bfhi(bw.y), bflo(bw.z), bfhi(bw.z), bflo(bw.w), bfhi(bw.w)};
#pragma unroll
                    for (int e = 0; e < 4; ++e) { acc[ai][bj][m][0][e] *= ga[e] / (fmaxf(gb[e], 1e-18f) * r); acc[ai][bj][m][1][e] *= ga[4 + e] / (fmaxf(gb[4 + e], 1e-18f) * r); } }
                asm volatile("" ::: "memory"); }
    }
    __device__ __forceinline__ void operator()(const f32x4 (&acc)[2][2][4][2], const Unit& u, int wr, int wc, int fr, int fq) const {
        int lr0 = wr * 64 + fr, col0 = u.pn * BM + wc * 32 + 8 * fq; asm volatile("" : "+v"(lr0), "+v"(col0));
#pragma unroll
        for (int ai = 0; ai < 2; ++ai)
#pragma unroll
            for (int m = 0; m < 4; ++m) { const int lr = lr0 + ai * HALF + m * 16; const float r = rsl[lr]; const size_t off = (size_t)(u.pm * BM + lr) * 1024 + col0;
#pragma unroll
                for (int bj = 0; bj < 2; ++bj) { const u32x4 bw = *(const u32x4*)(GB + off + bj * HALF);
                    const float gb[8] = {bflo(bw.x), bfhi(bw.x), bflo(bw.y), bfhi(bw.y), bflo(bw.z), bfhi(bw.z), bflo(bw.w), bfhi(bw.w)}; float o[8];
#pragma unroll
                    for (int e = 0; e < 4; ++e) { o[e] = acc[ai][bj][m][0][e] * (fmaxf(gb[e], 1e-18f) * r); o[4 + e] = acc[ai][bj][m][1][e] * (fmaxf(gb[4 + e], 1e-18f) * r); }
                    u32x4 w; w.x = cvt_pk_bf16(o[0], o[1]); w.y = cvt_pk_bf16(o[2], o[3]); w.z = cvt_pk_bf16(o[4], o[5]); w.w = cvt_pk_bf16(o[6], o[7]);
                    *(u32x4*)(O + off + bj * HALF) = w; }
                asm volatile("" ::: "memory"); }
    }
};
struct EpiSwiglu {
    static constexpr bool PERM = true, AFTER_DRAIN = false, HAS_MID = false;
    bf16_t* O;
    __device__ __forceinline__ void operator()(const f32x4 (&acc)[2][2][4][2], const Unit& u, int wr, int wc, int fr, int fq) const {
        const int row0 = u.pm * BM + wr * 64 + fr, col0 = u.pn * HALF + wc * 32 + 8 * fq;
#pragma unroll
        for (int ai = 0; ai < 2; ++ai)
#pragma unroll
            for (int m = 0; m < 4; ++m) { bf16_t* rowp = O + (size_t)(row0 + ai * HALF + m * 16) * 2816 + col0;
                const f32x4 g0 = acc[ai][0][m][0], g1 = acc[ai][0][m][1], u0 = acc[ai][1][m][0], u1 = acc[ai][1][m][1];
                float o[8];
#pragma unroll
                for (int e = 0; e < 4; ++e) { o[e] = siluf_(g0[e]) * u0[e]; o[4 + e] = siluf_(g1[e]) * u1[e]; }
                u32x4 w; w.x = cvt_pk_bf16(o[0], o[1]); w.y = cvt_pk_bf16(o[2], o[3]); w.z = cvt_pk_bf16(o[4], o[5]); w.w = cvt_pk_bf16(o[6], o[7]);
                *(u32x4*)rowp = w; }
    }
};
}

typedef float f32x16 __attribute__((ext_vector_type(16)));
__device__ __forceinline__ int rowoff(int r, int h) { return (r & 3) + 8 * (r >> 2) + 4 * h; }
struct Frame {
    LAS unsigned char* lds;
    volatile LAS unsigned* MISC;
    gu32* ctl;
    int tid, lane, wave, G;
    const float* const* in; float* out; unsigned char* ws;
};
#define WSP(T, off) ((T*)(F.ws + (off)))

__device__ __forceinline__ void cvt_item(const float* W, int K  , int Nsrc, bf16* WT, int n0dst, int srccol0, int k0, const float* kscale, LAS float* scr, int lane, int kd0 = 0) {
#pragma unroll 8
    for (int i = 0; i < 32; ++i) { const int kk = 2 * i + (lane >> 5); float v = 0.f;
        if (srccol0 >= 0) { v = W[(size_t)(k0 + kk) * Nsrc + srccol0 + (lane & 31)]; if (kscale) v *= kscale[k0 + kk]; }
        scr[kk * 33 + (lane & 31)] = v; }
    LDS_WAIT(); asm volatile("" ::: "memory");
    const int c = lane & 7;
#pragma unroll
    for (int j = 0; j < 4; ++j) { const int n = (lane >> 3) + 8 * j; const LAS float* s = scr + (8 * c) * 33 + n;
        v4u o; o.x = pk2(s[0 * 33], s[1 * 33]); o.y = pk2(s[2 * 33], s[3 * 33]); o.z = pk2(s[4 * 33], s[5 * 33]); o.w = pk2(s[6 * 33], s[7 * 33]);
        *(v4u*)(WT + (size_t)(n0dst + n) * K + kd0 + k0 + 8 * c) = o; }
    LDS_WAIT(); asm volatile("" ::: "memory");
}
__device__ __forceinline__ int win_srccol(int n) { return n < 6144 ? n : (n < 8192 ? n + 32 : (n < 8224 ? 6144 + (n - 8192) : -1)); }
__device__ __forceinline__ int wfi_srccol(int n) { const int t = n >> 8, r = n & 255; return r < 128 ? 128 * t + r : DFF + 128 * t + (r - 128); }

__device__ __forceinline__ void p0_weights(Frame& F) {
    LAS float* scr = (LAS float*)(F.lds + F.wave * 16384);
    const int gw = blockIdx.x * NWAVES + F.wave, NGW = F.G * NWAVES;
    constexpr int I_IN = 16 * (NPROJ / 32), I_SQ = 16 * 32, I_SSD = 32 * 32, I_FI = 16 * (2 * DFF / 32), I_FO = (DFF / 64) * 32;
    constexpr int NITEMS = I_IN + 3 * I_SQ + I_SSD + I_FI + I_FO;
    for (int it = gw; it < NITEMS; it += NGW) {
        int r = it;
        if (r < I_IN) { const int nblk = NPROJ / 32, kb = r / nblk, nb = r % nblk; cvt_item(F.in[I_WIN], 1024, 8224, WSP(bf16, WS_WIN), 32 * nb, win_srccol(32 * nb), 64 * kb, nullptr, scr, F.lane); continue; } r -= I_IN;
        if (r < I_SQ) { const int kb = r / 32, nb = r % 32; cvt_item(F.in[I_WGLU], 1024, 1024, WSP(bf16, WS_WGLU), 32 * nb, 32 * nb, 64 * kb, nullptr, scr, F.lane); continue; } r -= I_SQ;
        if (r < I_SQ) { const int kb = r / 32, nb = r % 32; cvt_item(F.in[I_WBS5], 3072, 1024, WSP(bf16, WS_WBR), 32 * nb, 32 * nb, 64 * kb, nullptr, scr, F.lane, 0); continue; } r -= I_SQ;
        if (r < I_SQ) { const int kb = r / 32, nb = r % 32; cvt_item(F.in[I_WOUT], 1024, 1024, WSP(bf16, WS_WOUT), 32 * nb, 32 * nb, 64 * kb, nullptr, scr, F.lane); continue; } r -= I_SQ;
        if (r < I_SSD) { const int kb = r / 32, nb = r % 32; cvt_item(F.in[I_WBSSD], 3072, 1024, WSP(bf16, WS_WBR), 32 * nb, 32 * nb, 64 * kb, F.in[I_MNORM], scr, F.lane, 1024); continue; } r -= I_SSD;
        if (r < I_FI) { const int nblk = 2 * DFF / 32, kb = r / nblk, nb = r % nblk; cvt_item(F.in[I_WFI], 1024, 2 * DFF, WSP(bf16, WS_WFI), 32 * nb, wfi_srccol(32 * nb), 64 * kb, nullptr, scr, F.lane); continue; } r -= I_FI;
        { const int kb = r / 32, nb = r % 32; cvt_item(F.in[I_WFO], DFF, 1024, WSP(bf16, WS_WFO), 32 * nb, 32 * nb, 64 * kb, nullptr, scr, F.lane); }
    }
}
__device__ __forceinline__ void p0_mod(Frame& F) {
    LAS float* sc = (LAS float*)F.lds;
    const float* cp = F.in[I_CP]; const float* cs = F.in[I_CS]; const float* W = F.in[I_WADA]; const float* bA = F.in[I_BADA]; float* MOD = WSP(float, WS_MOD);
    const int mt = (int)blockIdx.x % 5, ci = (int)blockIdx.x / 5, cnt = (F.G - mt + 4) / 5;
    const int lane = F.lane, r32 = lane & 31, hh = lane >> 5;
    for (int e = F.tid; e < 32 * 256; e += 512) { const int rr = e >> 8, k4 = (e & 255) * 4, r = 32 * mt + rr; f32x4 v = (f32x4){0.f, 0.f, 0.f, 0.f};
        if (r < NMOD) { v = (r < NBATCH) ? *(const f32x4*)(cp + r * 1024 + k4) : *(const f32x4*)(cs + (r - NBATCH) * 1024 + k4);
#pragma unroll
            for (int j = 0; j < 4; ++j) v[j] = v[j] / (1.0f + __expf(-v[j])); }
        *(LAS f32x4*)(sc + rr * 1028 + k4) = v; }
    __syncthreads();
    for (int nt = ci + cnt * F.wave; nt < 6144 / 32; nt += cnt * NWAVES) {
        const int n = nt * 32 + r32; const float* wp = W + (size_t)(hh * 512) * 6144 + n; const LAS float* ap = sc + r32 * 1028 + hh * 512;
        f32x16 acc;
#pragma unroll
        for (int r = 0; r < 16; ++r) acc[r] = 0.f;
#pragma unroll 2
        for (int s0 = 0; s0 < 512; s0 += 8) {
            float bw[8];
#pragma unroll
            for (int j = 0; j < 8; ++j) bw[j] = wp[(size_t)(s0 + j) * 6144];
            const f32x4 a0 = *(const LAS f32x4*)(ap + s0), a1 = *(const LAS f32x4*)(ap + s0 + 4);
#pragma unroll
            for (int j = 0; j < 4; ++j) acc = __builtin_amdgcn_mfma_f32_32x32x2f32(a0[j], bw[j], acc, 0, 0, 0);
#pragma unroll
            for (int j = 0; j < 4; ++j) acc = __builtin_amdgcn_mfma_f32_32x32x2f32(a1[j], bw[4 + j], acc, 0, 0, 0);
        }
        const float bb = bA[n];
#pragma unroll
        for (int r = 0; r < 16; ++r) { const int row = 32 * mt + rowoff(r, hh); if (row < NMOD) MOD[(size_t)row * 6144 + n] = acc[r] + bb; }
    }
    __syncthreads();
}
__device__ __forceinline__ void p0_s5consts(Frame& F) {
    const int gt = blockIdx.x * 512 + F.tid;
    if (gt < G5 * N5) {
        const int g = gt >> 6;
        const float lr = F.in[I_LRE][gt], li = F.in[I_LIM][gt], dt = expf(F.in[I_LDT][g]);
        const float th = li * dt, cs = cosf(th), sn = sinf(th), em1 = expm1f(lr * dt), mag = em1 + 1.0f, sh = sinf(0.5f * th);
        const float are = mag * cs, aim = mag * sn;
        const float nr = em1 * cs - 2.0f * sh * sh, ni = aim, den = lr * lr + li * li;
        const float fre = (nr * lr + ni * li) / den, fim = (ni * lr - nr * li) / den;
        float* AB = WSP(float, WS_ABAR); float* BB = WSP(float, WS_BBAR);
        AB[gt] = are; AB[G5 * N5 + gt] = aim;
        for (int h = 0; h < H5; ++h) { const float br = F.in[I_BRE][gt * 16 + h], bi = F.in[I_BIM][gt * 16 + h];
            BB[gt * 16 + h] = fre * br - fim * bi; BB[G5 * N5 * 16 + gt * 16 + h] = fre * bi + fim * br; }
    }
}
__device__ __forceinline__ const float* xrow(Frame& F, int m) { return m < MP ? F.in[I_XP] + (size_t)m * DM : F.in[I_XS] + (size_t)(m - MP) * DM; }
__device__ __forceinline__ int modrow(int m) { return m < MP ? (m >> 11) : NBATCH + (m - MP); }
__device__ __forceinline__ void p1_norm(Frame& F) {
    const int gw = blockIdx.x * NWAVES + F.wave, NGW = F.G * NWAVES;
    const float* gpm = F.in[I_NPM]; const float* MOD = WSP(float, WS_MOD); bf16* H = WSP(bf16, WS_H);
    for (int m = gw; m < MPAD; m += NGW) {
        unsigned long long* o8 = (unsigned long long*)(H + (size_t)m * DM) + F.lane;
        if (m >= MT) {
#pragma unroll
            for (int j = 0; j < 4; ++j) o8[64 * j] = 0ull;
            continue; }
        const f32x4* xr = (const f32x4*)xrow(F, m) + F.lane; const float* mr = MOD + (size_t)modrow(m) * 6144;
        f32x4 v[4]; float s2 = 0.f;
#pragma unroll
        for (int j = 0; j < 4; ++j) { v[j] = xr[64 * j]; s2 += (v[j].x * v[j].x + v[j].y * v[j].y) + (v[j].z * v[j].z + v[j].w * v[j].w); }
        const float rstd = 1.0f / sqrtf(wave_sum(s2) * (1.f / DM) + EPS);
#pragma unroll
        for (int j = 0; j < 4; ++j) { const int c = 4 * F.lane + 256 * j; const f32x4 g = *(const f32x4*)(gpm + c), sh = *(const f32x4*)(mr + c), sc = *(const f32x4*)(mr + 1024 + c);
            const f32x4 h = (v[j] * rstd) * g * (sc + 1.0f) + sh;
            o8[64 * j] = (unsigned long long)pk2(h.x, h.y) | ((unsigned long long)pk2(h.z, h.w) << 32); }
    }
}
__device__ __forceinline__ void unpack8(const v4u w, float (&f)[8]) { f[0] = bflo(w.x); f[1] = bfhi(w.x); f[2] = bflo(w.y); f[3] = bfhi(w.y); f[4] = bflo(w.z); f[5] = bfhi(w.z); f[6] = bflo(w.w); f[7] = bfhi(w.w); }
__device__ __forceinline__ void p_conv(Frame& F) {
    const bf16* XBC = WSP(bf16, WS_XBC); bf16* ACT = WSP(bf16, WS_ACT); const float* cw = F.in[I_CW]; const float* cb = F.in[I_CB]; const float* sconv = F.in[I_CONV];
    const int total = (MP / 16) * (CDIM / 8);
    for (int it = (int)blockIdx.x * 512 + F.tid; it < total; it += F.G * 512) {
        const int rb = it / (CDIM / 8), c0 = (it % (CDIM / 8)) * 8, m0 = rb * 16, t0 = m0 & (SEQ - 1);
        float wk[4][8], bias[8];
#pragma unroll
        for (int k = 0; k < 4; ++k) { const f32x4 a = *(const f32x4*)(cw + k * CDIM + c0), b2 = *(const f32x4*)(cw + k * CDIM + c0 + 4); wk[k][0] = a[0]; wk[k][1] = a[1]; wk[k][2] = a[2]; wk[k][3] = a[3]; wk[k][4] = b2[0]; wk[k][5] = b2[1]; wk[k][6] = b2[2]; wk[k][7] = b2[3]; }
        { const f32x4 a = *(const f32x4*)(cb + c0), b2 = *(const f32x4*)(cb + c0 + 4); bias[0] = a[0]; bias[1] = a[1]; bias[2] = a[2]; bias[3] = a[3]; bias[4] = b2[0]; bias[5] = b2[1]; bias[6] = b2[2]; bias[7] = b2[3]; }
        float h0[8], h1[8], h2[8];
        if (t0 == 0) {
#pragma unroll
            for (int e = 0; e < 8; ++e) { h0[e] = 0.f; h1[e] = 0.f; h2[e] = 0.f; }
        } else { unpack8(*(const v4u*)(XBC + (size_t)(m0 - 3) * CDIM + c0), h0); unpack8(*(const v4u*)(XBC + (size_t)(m0 - 2) * CDIM + c0), h1); unpack8(*(const v4u*)(XBC + (size_t)(m0 - 1) * CDIM + c0), h2); }
        v4u raw[16];
#pragma unroll
        for (int r = 0; r < 16; ++r) raw[r] = *(const v4u*)(XBC + (size_t)(m0 + r) * CDIM + c0);
#pragma unroll
        for (int r = 0; r < 16; ++r) { float x[8], a[8]; unpack8(raw[r], x);
#pragma unroll
            for (int e = 0; e < 8; ++e) { const float v = bias[e] + wk[0][e] * h0[e] + wk[1][e] * h1[e] + wk[2][e] * h2[e] + wk[3][e] * x[e]; a[e] = siluf_(v); h0[e] = h1[e]; h1[e] = h2[e]; h2[e] = x[e]; }
            v4u o; o.x = pk2(a[0], a[1]); o.y = pk2(a[2], a[3]); o.z = pk2(a[4], a[5]); o.w = pk2(a[6], a[7]);
            *(v4u*)(ACT + (size_t)(m0 + r) * CDIM + c0) = o; }
        if (t0 == SEQ - 16) { float* o = F.out + O_CONVP + ((size_t)(m0 >> 11) * 3) * CDIM + c0;
#pragma unroll
            for (int e = 0; e < 8; ++e) { o[e] = h0[e]; o[CDIM + e] = h1[e]; o[2 * CDIM + e] = h2[e]; } }
    }
    for (int it = (int)blockIdx.x * 512 + F.tid; it < MS * (CDIM / 8); it += F.G * 512) {
        const int s_ = it / (CDIM / 8), c0 = (it % (CDIM / 8)) * 8, m = MP + s_;
        float tap[4][8];
#pragma unroll
        for (int k = 0; k < 3; ++k) { const float* sp = sconv + ((size_t)s_ * 3 + k) * CDIM + c0;
#pragma unroll
            for (int e = 0; e < 8; ++e) tap[k][e] = sp[e]; }
        unpack8(*(const v4u*)(XBC + (size_t)m * CDIM + c0), tap[3]);
#pragma unroll
        for (int k = 0; k < 3; ++k) { float* o = F.out + O_CONVS + ((size_t)s_ * 3 + k) * CDIM + c0;
#pragma unroll
            for (int e = 0; e < 8; ++e) o[e] = tap[k + 1][e]; }
        float a[8];
#pragma unroll
        for (int e = 0; e < 8; ++e) { float v = cb[c0 + e];
#pragma unroll
            for (int k = 0; k < 4; ++k) v += cw[k * CDIM + c0 + e] * tap[k][e];
            a[e] = siluf_(v); }
        v4u o; o.x = pk2(a[0], a[1]); o.y = pk2(a[2], a[3]); o.z = pk2(a[4], a[5]); o.w = pk2(a[6], a[7]);
        *(v4u*)(ACT + (size_t)m * CDIM + c0) = o;
    }
}
__device__ __forceinline__ void s5_prompt_unit(Frame& F, int b, int g, LAS float* wl) {
    LAS float* XR = wl; LAS float* XI = wl + 64 * 65; LAS float* CR = wl + 2 * 64 * 65; LAS float* CI = CR + 16 * 64;
    const int n = F.lane; const float* AB = WSP(float, WS_ABAR); const float* BB = WSP(float, WS_BBAR);
    const float abr = AB[g * 64 + n], abi = AB[G5 * N5 + g * 64 + n];
    float bre[16], bim[16];
#pragma unroll
    for (int h = 0; h < 16; ++h) { bre[h] = BB[(g * 64 + n) * 16 + h]; bim[h] = BB[G5 * N5 * 16 + (g * 64 + n) * 16 + h]; }
    for (int h = 0; h < 16; ++h) { CR[h * 64 + n] = F.in[I_CRE][(g * 16 + h) * 64 + n]; CI[h * 64 + n] = F.in[I_CIM][(g * 16 + h) * 64 + n]; }
    float dsk[16];
#pragma unroll
    for (int h = 0; h < 16; ++h) dsk[h] = F.in[I_S5D][g * 16 + h];
    const bf16* U = WSP(bf16, WS_U); bf16* YA = WSP(bf16, WS_YA);
    float xr = 0.f, xi = 0.f;
    for (int tb = 0; tb < SEQ / 64; ++tb) {
        const size_t rowb = (size_t)b * SEQ + tb * 64;
        for (int tt = 0; tt < 64; ++tt) {
            const v4u w0 = *(const v4u*)(U + (rowb + tt) * DM + g * 16), w1 = *(const v4u*)(U + (rowb + tt) * DM + g * 16 + 8);
            const float uv[16] = {bflo(w0.x), bfhi(w0.x), bflo(w0.y), bfhi(w0.y), bflo(w0.z), bfhi(w0.z), bflo(w0.w), bfhi(w0.w), bflo(w1.x), bfhi(w1.x), bflo(w1.y), bfhi(w1.y), bflo(w1.z), bfhi(w1.z), bflo(w1.w), bfhi(w1.w)};
            float bur = 0.f, bui = 0.f;
#pragma unroll
            for (int h = 0; h < 16; ++h) { bur += bre[h] * uv[h]; bui += bim[h] * uv[h]; }
            const float nxr = abr * xr - abi * xi + bur, nxi = abr * xi + abi * xr + bui; xr = nxr; xi = nxi;
            XR[tt * 65 + n] = xr; XI[tt * 65 + n] = xi;
        }
        LDS_WAIT(); asm volatile("" ::: "memory");
        float acc[16];
#pragma unroll
        for (int h = 0; h < 16; ++h) acc[h] = 0.f;
        for (int n2 = 0; n2 < 64; ++n2) { const float a = XR[F.lane * 65 + n2], c = XI[F.lane * 65 + n2];
#pragma unroll
            for (int h = 0; h < 16; ++h) acc[h] += CR[h * 64 + n2] * a - CI[h * 64 + n2] * c; }
        {
            const size_t row = rowb + F.lane;
            const v4u w0 = *(const v4u*)(U + row * DM + g * 16), w1 = *(const v4u*)(U + row * DM + g * 16 + 8);
            const float uv[16] = {bflo(w0.x), bfhi(w0.x), bflo(w0.y), bfhi(w0.y), bflo(w0.z), bfhi(w0.z), bflo(w0.w), bfhi(w0.w), bflo(w1.x), bfhi(w1.x), bflo(w1.y), bfhi(w1.y), bflo(w1.z), bfhi(w1.z), bflo(w1.w), bfhi(w1.w)};
            float o[16];
#pragma unroll
            for (int h = 0; h < 16; ++h) o[h] = gelu_tanh(acc[h] + dsk[h] * uv[h]);
            v4u p0, p1; p0.x = pk2(o[0], o[1]); p0.y = pk2(o[2], o[3]); p0.z = pk2(o[4], o[5]); p0.w = pk2(o[6], o[7]); p1.x = pk2(o[8], o[9]); p1.y = pk2(o[10], o[11]); p1.z = pk2(o[12], o[13]); p1.w = pk2(o[14], o[15]);
            *(v4u*)(YA + row * DM + g * 16) = p0; *(v4u*)(YA + row * DM + g * 16 + 8) = p1;
        }
        LDS_WAIT(); asm volatile("" ::: "memory");
    }
    F.out[O_S5RP + (size_t)(b * G5 + g) * N5 + n] = xr; F.out[O_S5IP + (size_t)(b * G5 + g) * N5 + n] = xi;
}
__device__ __forceinline__ void s5_sample_unit(Frame& F, int s, int g) {
    const int n = F.lane; const float* AB = WSP(float, WS_ABAR); const float* BB = WSP(float, WS_BBAR);
    const float abr = AB[g * 64 + n], abi = AB[G5 * N5 + g * 64 + n];
    const bf16* U = WSP(bf16, WS_U); bf16* YA = WSP(bf16, WS_YA);
    const size_t row = (size_t)MP + s;
    const v4u w0 = *(const v4u*)(U + row * DM + g * 16), w1 = *(const v4u*)(U + row * DM + g * 16 + 8);
    const float uv[16] = {bflo(w0.x), bfhi(w0.x), bflo(w0.y), bfhi(w0.y), bflo(w0.z), bfhi(w0.z), bflo(w0.w), bfhi(w0.w), bflo(w1.x), bfhi(w1.x), bflo(w1.y), bfhi(w1.y), bflo(w1.z), bfhi(w1.z), bflo(w1.w), bfhi(w1.w)};
    float bur = 0.f, bui = 0.f;
#pragma unroll
    for (int h = 0; h < 16; ++h) { bur += BB[(g * 64 + n) * 16 + h] * uv[h]; bui += BB[G5 * N5 * 16 + (g * 64 + n) * 16 + h] * uv[h]; }
    const size_t si = ((size_t)s * G5 + g) * N5 + n;
    const float h0r = F.in[I_S5RE][si], h0i = F.in[I_S5IM][si];
    const float xr = abr * h0r - abi * h0i + bur, xi = abr * h0i + abi * h0r + bui;
    F.out[O_S5RS + si] = xr; F.out[O_S5IS + si] = xi;
    float o[16];
#pragma unroll
    for (int h = 0; h < 16; ++h) { const float y = wave_sum(F.in[I_CRE][(g * 16 + h) * 64 + n] * xr - F.in[I_CIM][(g * 16 + h) * 64 + n] * xi); o[h] = gelu_tanh(y + F.in[I_S5D][g * 16 + h] * uv[h]); }
    if (n == 0) { v4u p0, p1; p0.x = pk2(o[0], o[1]); p0.y = pk2(o[2], o[3]); p0.z = pk2(o[4], o[5]); p0.w = pk2(o[6], o[7]); p1.x = pk2(o[8], o[9]); p1.y = pk2(o[10], o[11]); p1.z = pk2(o[12], o[13]); p1.w = pk2(o[14], o[15]);
        *(v4u*)(YA + row * DM + g * 16) = p0; *(v4u*)(YA + row * DM + g * 16 + 8) = p1; }
}
typedef short s16x4 __attribute__((ext_vector_type(4)));
__device__ __forceinline__ unsigned offB(unsigned row, unsigned ch) { return 256u * row + 16u * (ch ^ (((row & 3u) << 2) | ((row >> 2) & 3u))); }
__device__ __forceinline__ unsigned offX(unsigned row, unsigned ch) { return 128u * row + 16u * (ch ^ (((row >> 1) & 1u) << 2)); }
__device__ __forceinline__ unsigned offG(unsigned row, unsigned ch) { return 128u * row + 16u * (ch ^ ((row >> 1) & 7u)); }
__device__ __forceinline__ bf16x8 tr_frag(LAS unsigned char* base, unsigned a0, unsigned a1) {
    const s16x4 lo = __builtin_bit_cast(s16x4, __builtin_amdgcn_ds_read_tr16_b64_v4i16((LAS s16x4*)(base + a0)));
    const s16x4 hi = __builtin_bit_cast(s16x4, __builtin_amdgcn_ds_read_tr16_b64_v4i16((LAS s16x4*)(base + a1)));
    return (bf16x8){lo[0], lo[1], lo[2], lo[3], hi[0], hi[1], hi[2], hi[3]};
}
constexpr int SL_BM = 0, SL_CM = 16384, SL_HS = 32768, SL_XS = 49152  , SL_ZT = 65536  , SL_XT = 81920, SL_XW = 90112, SL_GL = 98304, SL_YS = 106496  , SL_TB = 122880;
__device__ __forceinline__ void ssd_prompt_mfma(Frame& F, int b, int head) {
    LAS unsigned char* L = F.lds;
    const bf16* ACT = WSP(bf16, WS_ACT); const bf16* Z = WSP(bf16, WS_Z); const float* DT = WSP(float, WS_DT); bf16* GY = WSP(bf16, WS_GY); float* SSQ = WSP(float, WS_SSQ);
    const int tid = F.tid, lane = F.lane, w = F.wave, grp = head >> 3, r32 = lane & 31, hh = lane >> 5;
    const float A = -expf(F.in[I_ALOG][head]), Dh = F.in[I_MD][head];
    const size_t rowb = (size_t)b * SEQ;
    LAS float* TB_CS = (LAS float*)(L + SL_TB); LAS float* TB_ECS = TB_CS + 64;
    for (int e = tid; e < 16384 / 16; e += 512) *(LAS v4u*)(L + SL_HS + e * 16) = (v4u){0u, 0u, 0u, 0u};
    f32x16 hacc;
#pragma unroll
    for (int r = 0; r < 16; ++r) hacc[r] = 0.f;
    const int lB0 = tid >> 4, chB = tid & 15, lB1 = lB0 + 32, lX = tid >> 3, chX = tid & 7;
    v4u pfB0, pfB1, pfC0, pfC1, pfX, pfZ; float pfdt;
    {   const size_t r0 = rowb;
        pfB0 = *(const v4u*)(ACT + (r0 + lB0) * CDIM + 2048 + grp * 128 + chB * 8); pfB1 = *(const v4u*)(ACT + (r0 + lB1) * CDIM + 2048 + grp * 128 + chB * 8);
        pfC0 = *(const v4u*)(ACT + (r0 + lB0) * CDIM + 2560 + grp * 128 + chB * 8); pfC1 = *(const v4u*)(ACT + (r0 + lB1) * CDIM + 2560 + grp * 128 + chB * 8);
        pfX = *(const v4u*)(ACT + (r0 + lX) * CDIM + head * 64 + chX * 8); pfZ = *(const v4u*)(Z + (r0 + lX) * MIN + head * 64 + chX * 8);
        pfdt = DT[(r0 + lane) * 32 + head]; }
    const unsigned tq = (lane & 15) >> 2, tp = lane & 3, tblk = (lane >> 4) & 1;
    for (int c = 0; c <= SEQ / 64; ++c) {
        const int buf = c & 1;
        if (c > 0) {
            const int pb = buf ^ 1; const size_t row = rowb + (size_t)(c - 1) * 64 + lX;
            const f32x4 y0 = *(const LAS f32x4*)(L + SL_YS + lX * 256 + chX * 32), y1 = *(const LAS f32x4*)(L + SL_YS + lX * 256 + chX * 32 + 16);
            const v4u xw = *(const LAS v4u*)(L + SL_XS + pb * 8192 + offX(lX, chX)), zw = *(const LAS v4u*)(L + SL_ZT + pb * 8192 + lX * 128 + chX * 16);
            const float yv[8] = {y0[0], y0[1], y0[2], y0[3], y1[0], y1[1], y1[2], y1[3]};
            const float xv[8] = {bflo(xw.x), bfhi(xw.x), bflo(xw.y), bfhi(xw.y), bflo(xw.z), bfhi(xw.z), bflo(xw.w), bfhi(xw.w)};
            const float zv[8] = {bflo(zw.x), bfhi(zw.x), bflo(zw.y), bfhi(zw.y), bflo(zw.z), bfhi(zw.z), bflo(zw.w), bfhi(zw.w)};
            float o[8];
#pragma unroll
            for (int e = 0; e < 8; ++e) o[e] = (yv[e] + Dh * xv[e]) * siluf_(zv[e]);
            v4u ow; ow.x = pk2(o[0], o[1]); ow.y = pk2(o[2], o[3]); ow.z = pk2(o[4], o[5]); ow.w = pk2(o[6], o[7]);
            *(v4u*)(GY + row * 3072 + 1024 + head * 64 + chX * 8) = ow;
            float q2 = (o[0] * o[0] + o[1] * o[1]) + (o[2] * o[2] + o[3] * o[3]) + (o[4] * o[4] + o[5] * o[5]) + (o[6] * o[6] + o[7] * o[7]);
            q2 += __shfl_xor(q2, 1); q2 += __shfl_xor(q2, 2); q2 += __shfl_xor(q2, 4);
            if (chX == 0) SSQ[row * 32 + head] = q2;
        }
        if (c == SEQ / 64) break;
        *(LAS v4u*)(L + SL_BM + offB(lB0, chB)) = pfB0; *(LAS v4u*)(L + SL_BM + offB(lB1, chB)) = pfB1;
        *(LAS v4u*)(L + SL_CM + offB(lB0, chB)) = pfC0; *(LAS v4u*)(L + SL_CM + offB(lB1, chB)) = pfC1;
        *(LAS v4u*)(L + SL_XS + buf * 8192 + offX(lX, chX)) = pfX; *(LAS v4u*)(L + SL_ZT + buf * 8192 + lX * 128 + chX * 16) = pfZ;
        float cs = pfdt * A;
#pragma unroll
        for (int o = 1; o < 64; o <<= 1) { const float t = __shfl_up(cs, o); if (lane >= o) cs += t; }
        const float cs_last = __shfl(cs, 63);
        if (w == 0) { TB_CS[lane] = cs; TB_ECS[lane] = __expf(cs); }
        {   const float dtl = __shfl(pfdt, lX), wl = __expf(cs_last - __shfl(cs, lX));
            const float xv[8] = {bflo(pfX.x), bfhi(pfX.x), bflo(pfX.y), bfhi(pfX.y), bflo(pfX.z), bfhi(pfX.z), bflo(pfX.w), bfhi(pfX.w)};
            float xd[8], xq[8];
#pragma unroll
            for (int e = 0; e < 8; ++e) { xd[e] = xv[e] * dtl; xq[e] = xd[e] * wl; }
            v4u a, q; a.x = pk2(xd[0], xd[1]); a.y = pk2(xd[2], xd[3]); a.z = pk2(xd[4], xd[5]); a.w = pk2(xd[6], xd[7]); q.x = pk2(xq[0], xq[1]); q.y = pk2(xq[2], xq[3]); q.z = pk2(xq[4], xq[5]); q.w = pk2(xq[6], xq[7]);
            *(LAS v4u*)(L + SL_XT + offX(lX, chX)) = a; *(LAS v4u*)(L + SL_XW + offX(lX, chX)) = q; }
        const float decay = __expf(cs_last);
        if (c + 1 < SEQ / 64) { const size_t r0 = rowb + (size_t)(c + 1) * 64;
            pfB0 = *(const v4u*)(ACT + (r0 + lB0) * CDIM + 2048 + grp * 128 + chB * 8); pfB1 = *(const v4u*)(ACT + (r0 + lB1) * CDIM + 2048 + grp * 128 + chB * 8);
            pfC0 = *(const v4u*)(ACT + (r0 + lB0) * CDIM + 2560 + grp * 128 + chB * 8); pfC1 = *(const v4u*)(ACT + (r0 + lB1) * CDIM + 2560 + grp * 128 + chB * 8);
            pfX = *(const v4u*)(ACT + (r0 + lX) * CDIM + head * 64 + chX * 8); pfZ = *(const v4u*)(Z + (r0 + lX) * MIN + head * 64 + chX * 8);
            pfdt = DT[(r0 + lane) * 32 + head]; }
        __syncthreads();
        f32x16 yacc;
#pragma unroll
        for (int r = 0; r < 16; ++r) yacc[r] = 0.f;
        if (w < 4) {
            const int lt = w >> 1, pt = w & 1;
#pragma unroll
            for (int ks = 0; ks < 8; ++ks) { const bf16x8 a = *(const LAS bf16x8*)(L + SL_CM + offB(32 * lt + r32, 2 * ks + hh)), bb = *(const LAS bf16x8*)(L + SL_HS + offB(32 * pt + r32, 2 * ks + hh));
                yacc = __builtin_amdgcn_mfma_f32_32x32x16_bf16(a, bb, yacc, 0, 0, 0); }
#pragma unroll
            for (int r = 0; r < 16; ++r) yacc[r] *= TB_ECS[32 * lt + rowoff(r, hh)];
        } else if (w < 7) {
            const int lt = (w == 4) ? 0 : 1, st = (w == 6) ? 1 : 0;
            f32x16 g;
#pragma unroll
            for (int r = 0; r < 16; ++r) g[r] = 0.f;
#pragma unroll
            for (int ks = 0; ks < 8; ++ks) { const bf16x8 a = *(const LAS bf16x8*)(L + SL_CM + offB(32 * lt + r32, 2 * ks + hh)), bb = *(const LAS bf16x8*)(L + SL_BM + offB(32 * st + r32, 2 * ks + hh));
                g = __builtin_amdgcn_mfma_f32_32x32x16_bf16(a, bb, g, 0, 0, 0); }
            const int s = 32 * st + r32; const float css = TB_CS[s];
#pragma unroll
            for (int r = 0; r < 16; ++r) { const int l = 32 * lt + rowoff(r, hh); const float ex = __expf(fminf(TB_CS[l] - css, 0.f)); const float v = (s <= l) ? g[r] * ex : 0.f;
                *(LAS bf16*)(L + SL_GL + offG(l, s >> 3) + (s & 7) * 2) = (bf16)f2bf(v); }
        }
        {
            const int pt = w & 1, nt = w >> 1;
#pragma unroll
            for (int r = 0; r < 16; ++r) hacc[r] *= decay;
#pragma unroll
            for (int ks = 0; ks < 4; ++ks) { const unsigned k0 = 16 * ks + 8 * hh + tq;
                const bf16x8 a = tr_frag(L + SL_XW, offX(k0, 4 * pt + 2 * tblk + (tp >> 1)) + 8 * (tp & 1), offX(k0 + 4, 4 * pt + 2 * tblk + (tp >> 1)) + 8 * (tp & 1));
                const bf16x8 bb = tr_frag(L + SL_BM, offB(k0, 4 * nt + 2 * tblk + (tp >> 1)) + 8 * (tp & 1), offB(k0 + 4, 4 * nt + 2 * tblk + (tp >> 1)) + 8 * (tp & 1));
                hacc = __builtin_amdgcn_mfma_f32_32x32x16_bf16(a, bb, hacc, 0, 0, 0); }
        }
        __syncthreads();
        if (w < 4) {
            const int lt = w >> 1, pt = w & 1;
            for (int ks = 0; ks < 2 * (lt + 1); ++ks) { const unsigned k0 = 16 * ks + 8 * hh + tq;
                const bf16x8 a = *(const LAS bf16x8*)(L + SL_GL + offG(32 * lt + r32, 2 * ks + hh));
                const bf16x8 bb = tr_frag(L + SL_XT, offX(k0, 4 * pt + 2 * tblk + (tp >> 1)) + 8 * (tp & 1), offX(k0 + 4, 4 * pt + 2 * tblk + (tp >> 1)) + 8 * (tp & 1));
                yacc = __builtin_amdgcn_mfma_f32_32x32x16_bf16(a, bb, yacc, 0, 0, 0); }
#pragma unroll
            for (int r = 0; r < 16; ++r) *(LAS float*)(L + SL_YS + (32 * lt + rowoff(r, hh)) * 256 + (32 * pt + r32) * 4) = yacc[r];
        }
        {   const int pt = w & 1, nt = w >> 1; const int n = 32 * nt + r32;
#pragma unroll
            for (int r = 0; r < 16; ++r) { const int p = 32 * pt + rowoff(r, hh); *(LAS bf16*)(L + SL_HS + offB(p, n >> 3) + (n & 7) * 2) = (bf16)f2bf(hacc[r]); }
        }
        __syncthreads();
    }
    {   float* ho = F.out + O_SSMP + (size_t)(b * NH + head) * HD * NST; const int pt = w & 1, nt = w >> 1;
#pragma unroll
        for (int r = 0; r < 16; ++r) ho[(size_t)(32 * pt + rowoff(r, hh)) * NST + 32 * nt + r32] = hacc[r];
    }
    __syncthreads();
}


__device__ __forceinline__ void p0_s5tables(Frame& F) {
    LAS float* PR = (LAS float*)F.lds; LAS float* PI = PR + 64 * 33; LAS float* BR = PI + 64 * 33; LAS float* BI = BR + 1024; LAS float* CR = BI + 1024; LAS float* CI = CR + 1024;
    bf16* KT = WSP(bf16, WS_KT); bf16* SMF = WSP(bf16, WS_SMF); bf16* OMF = WSP(bf16, WS_OMF); float* A32 = WSP(float, WS_A32);
    const int tid = F.tid;
    for (int job = blockIdx.x; job < G5 * 4; job += F.G) {
        const int g = job >> 2, q = job & 3;
        __syncthreads();
        const float dt = expf(F.in[I_LDT][g]);
        for (int e = tid; e < 64 * 33; e += 512) { const int n = e / 33, d = e % 33; const float lr = F.in[I_LRE][g * 64 + n], li = F.in[I_LIM][g * 64 + n];
            const float mg = expf(lr * dt * (float)d), th = li * dt * (float)d; PR[e] = mg * cosf(th); PI[e] = mg * sinf(th); }
        for (int e = tid; e < 1024; e += 512) { const int n = e >> 4; const float lr = F.in[I_LRE][g * 64 + n], li = F.in[I_LIM][g * 64 + n];
            const float th = li * dt, cs = cosf(th), sn = sinf(th), em1 = expm1f(lr * dt), mag = em1 + 1.0f, sh = sinf(0.5f * th);
            const float nr = em1 * cs - 2.0f * sh * sh, ni = mag * sn, den = lr * lr + li * li;
            const float fre = (nr * lr + ni * li) / den, fim = (ni * lr - nr * li) / den;
            const float br = F.in[I_BRE][(g * 64 + n) * 16 + (e & 15)], bi = F.in[I_BIM][(g * 64 + n) * 16 + (e & 15)];
            BR[e] = fre * br - fim * bi; BI[e] = fre * bi + fim * br; }
        for (int e = tid; e < 1024; e += 512) { CR[e] = F.in[I_CRE][g * 1024 + e]; CI[e] = F.in[I_CIM][g * 1024 + e]; }
        __syncthreads();
        for (int o = tid; o < 8 * 256; o += 512) { const int d = 8 * q + (o >> 8), h = (o >> 4) & 15, hp = o & 15; float acc = 0.f;
            for (int n = 0; n < 64; ++n) { const float cr = CR[h * 64 + n], ci = CI[h * 64 + n], pr = PR[n * 33 + d], pi = PI[n * 33 + d];
                acc += (cr * pr - ci * pi) * BR[n * 16 + hp] - (cr * pi + ci * pr) * BI[n * 16 + hp]; }
            KT[(size_t)(g * 33 + d + 1) * 256 + h * 16 + hp] = (bf16)f2bf(acc); }
        if (q == 0) { if (tid < 256) KT[(size_t)(g * 33) * 256 + tid] = 0; if (tid < 64) { A32[g * 64 + tid] = PR[tid * 33 + 32]; A32[G5 * N5 + g * 64 + tid] = PI[tid * 33 + 32]; } }
        for (int idx = tid; idx < 32 * 512; idx += 512) { const int jj = idx & 7, ln = (idx >> 3) & 63, ks = idx >> 9;
            const int rho = 32 * q + (ln & 31), ri = rho >> 6, n = rho & 63, hp = 8 * (ln >> 5) + jj, d = 31 - ks;
            const float pr = PR[n * 33 + d], pi = PI[n * 33 + d], br = BR[n * 16 + hp], bi = BI[n * 16 + hp];
            SMF[((size_t)(g * 4 + q) * 32 + ks) * 512 + ln * 8 + jj] = (bf16)f2bf(ri ? (pr * bi + pi * br) : (pr * br - pi * bi)); }
        for (int idx = tid; idx < 4 * 8 * 512; idx += 512) { const int jj = idx & 7, ln = (idx >> 3) & 63, ks = (idx >> 9) & 7, m = 4 * q + (idx >> 12);
            const int r32 = ln & 31, il = r32 >> 4, h = r32 & 15, i = 2 * m + il, kap = 16 * ks + 8 * (ln >> 5) + jj, ri = kap >> 6, n = kap & 63;
            const float pr = PR[n * 33 + i + 1], pi = PI[n * 33 + i + 1], cr = CR[h * 64 + n], ci = CI[h * 64 + n];
            OMF[((size_t)(g * 16 + m) * 8 + ks) * 512 + ln * 8 + jj] = (bf16)f2bf(ri ? (-cr * pi - ci * pr) : (cr * pr - ci * pi)); }
    }
    __syncthreads();
}
constexpr int S5_KT = 0, S5_UL = 17408, S5_SB = 51200, S5_XIN = 86016;
__device__ __forceinline__ void s5_prompt_mfma(Frame& F, int g, int bp) {
    LAS unsigned char* L = F.lds;
    const bf16* U = WSP(bf16, WS_U); bf16* YA = WSP(bf16, WS_YA); const bf16* SMF = WSP(bf16, WS_SMF); const bf16* OMF = WSP(bf16, WS_OMF); const float* A32 = WSP(float, WS_A32);
    const int tid = F.tid, lane = F.lane, w = F.wave, r32 = lane & 31, hh = lane >> 5;
    {   const v4u* src = (const v4u*)(WSP(bf16, WS_KT) + (size_t)g * 33 * 256);
        for (int e = tid; e < 33 * 512 / 16; e += 512) *(LAS v4u*)(L + S5_KT + e * 16) = src[e]; }
    float xr = 0.f, xi = 0.f; const float a32r = A32[g * 64 + lane], a32i = A32[G5 * N5 + g * 64 + lane];
    float dv[2][4];
#pragma unroll
    for (int x = 0; x < 2; ++x)
#pragma unroll
        for (int e = 0; e < 4; ++e) dv[x][e] = F.in[I_S5D][g * 16 + 8 * x + 4 * hh + e];
    LAS float* SB = (LAS float*)(L + S5_SB);
    for (int nt = 0; nt < 4; ++nt) {
        const int batch = 2 * bp + (nt >> 1); const size_t rowbase = (size_t)batch * SEQ + (size_t)(nt & 1) * 1024;
#pragma unroll
        for (int i = 0; i < 4; ++i) { const int e = tid + 512 * i, tau = e >> 1, half = e & 1;
            *(LAS v4u*)(L + S5_UL + (tau >> 5) * 1040 + (tau & 31) * 32 + half * 16) = *(const v4u*)(U + (rowbase + tau) * DM + g * 16 + 8 * half); }
        if ((nt & 1) == 0) { xr = 0.f; xi = 0.f; }
        __syncthreads();
        {   const int mt = w & 3, kh = w >> 2; f32x16 acc;
#pragma unroll
            for (int r = 0; r < 16; ++r) acc[r] = 0.f;
#pragma unroll 4
            for (int jj = 0; jj < 16; ++jj) { const int j = 16 * kh + jj;
                const bf16x8 a = *(const bf16x8*)(SMF + (((size_t)(g * 4 + mt) * 32 + j) * 64 + lane) * 8);
                const bf16x8 bb = *(const LAS bf16x8*)(L + S5_UL + r32 * 1040 + j * 32 + hh * 16);
                acc = __builtin_amdgcn_mfma_f32_32x32x16_bf16(a, bb, acc, 0, 0, 0); }
#pragma unroll
            for (int r = 0; r < 16; ++r) SB[(kh * 128 + 32 * mt + rowoff(r, hh)) * 33 + r32] = acc[r];
        }
        __syncthreads();
        if (w == 0) {
            const int n = lane;
            for (int c = 0; c < 32; ++c) {
                *(LAS bf16*)(L + S5_XIN + offB(c, n >> 3) + (n & 7) * 2) = (bf16)f2bf(xr); *(LAS bf16*)(L + S5_XIN + offB(c, 8 + (n >> 3)) + (n & 7) * 2) = (bf16)f2bf(xi);
                const float sr = SB[n * 33 + c] + SB[(128 + n) * 33 + c], si = SB[(64 + n) * 33 + c] + SB[(192 + n) * 33 + c];
                const float nr = a32r * xr - a32i * xi + sr, ni = a32r * xi + a32i * xr + si; xr = nr; xi = ni; }
            if (nt & 1) { F.out[O_S5RP + (size_t)(batch * G5 + g) * N5 + n] = xr; F.out[O_S5IP + (size_t)(batch * G5 + g) * N5 + n] = xi; }
        }
        __syncthreads();
        for (int mi = 0; mi < 2; ++mi) {
            const int m = mi ? 15 - w : w; f32x16 acc;
#pragma unroll
            for (int r = 0; r < 16; ++r) acc[r] = 0.f;
            for (int j = 0; j <= 2 * m + 1; ++j) { const int lag1 = 2 * m + (r32 >> 4) - j + 1;
                const bf16x8 a = *(const LAS bf16x8*)(L + S5_KT + (lag1 * 256 + (r32 & 15) * 16 + 8 * hh) * 2);
                const bf16x8 bb = *(const LAS bf16x8*)(L + S5_UL + r32 * 1040 + j * 32 + hh * 16);
                acc = __builtin_amdgcn_mfma_f32_32x32x16_bf16(a, bb, acc, 0, 0, 0); }
#pragma unroll
            for (int ks = 0; ks < 8; ++ks) { const bf16x8 a = *(const bf16x8*)(OMF + (((size_t)(g * 16 + m) * 8 + ks) * 64 + lane) * 8);
                const bf16x8 bb = *(const LAS bf16x8*)(L + S5_XIN + offB(r32, 2 * ks + hh));
                acc = __builtin_amdgcn_mfma_f32_32x32x16_bf16(a, bb, acc, 0, 0, 0); }
#pragma unroll
            for (int q = 0; q < 4; ++q) { const int il = q >> 1, h0 = 8 * (q & 1) + 4 * hh, j = 2 * m + il;
                const v2u uw = *(const LAS v2u*)(L + S5_UL + r32 * 1040 + j * 32 + h0 * 2);
                const float uv[4] = {bflo(uw.x), bfhi(uw.x), bflo(uw.y), bfhi(uw.y)}; float o[4];
#pragma unroll
                for (int e = 0; e < 4; ++e) o[e] = gelu_tanh(acc[4 * q + e] + dv[q & 1][e] * uv[e]);
                v2u ow; ow.x = pk2(o[0], o[1]); ow.y = pk2(o[2], o[3]);
                *(v2u*)(YA + (rowbase + (size_t)r32 * 32 + j) * DM + g * 16 + h0) = ow; }
        }
        __syncthreads();
    }
}

__device__ __forceinline__ void ssd_sample_waves(Frame& F) {
    const bf16* ACT = WSP(bf16, WS_ACT); const bf16* Z = WSP(bf16, WS_Z); const float* DT = WSP(float, WS_DT); bf16* GY = WSP(bf16, WS_GY);
    const float* S0 = F.in[I_SSM]; float* SO = F.out + O_SSMS;
    const int lane = F.lane, pp = lane >> 3, q = lane & 7, p = 8 * F.wave + pp;
    int u = blockIdx.x; if (u >= MS * NH) return;
    f32x4 hn[4];
#pragma unroll
    for (int j = 0; j < 4; ++j) hn[j] = *(const f32x4*)(S0 + ((size_t)u * HD + p) * NST + 32 * j + 4 * q);
    for (; u < MS * NH; u += F.G) {
        f32x4 h[4];
#pragma unroll
        for (int j = 0; j < 4; ++j) h[j] = hn[j];
        const int un = u + F.G;
        if (un < MS * NH) {
#pragma unroll
            for (int j = 0; j < 4; ++j) hn[j] = *(const f32x4*)(S0 + ((size_t)un * HD + p) * NST + 32 * j + 4 * q); }
        const int s_ = u >> 5, head = u & 31, grp = head >> 3; const size_t row = (size_t)MP + s_;
        const float dt = DT[row * 32 + head], a = __expf(-expf(F.in[I_ALOG][head]) * dt), xs = bf2f(ACT[row * CDIM + head * 64 + p]), xdt = xs * dt;
        float yp = 0.f;
#pragma unroll
        for (int j = 0; j < 4; ++j) { const v2u bw = *(const v2u*)(ACT + row * CDIM + 2048 + grp * 128 + 32 * j + 4 * q), cw2 = *(const v2u*)(ACT + row * CDIM + 2560 + grp * 128 + 32 * j + 4 * q);
            const float Bv[4] = {bflo(bw.x), bfhi(bw.x), bflo(bw.y), bfhi(bw.y)}, Cv[4] = {bflo(cw2.x), bfhi(cw2.x), bflo(cw2.y), bfhi(cw2.y)};
#pragma unroll
            for (int e = 0; e < 4; ++e) { h[j][e] = a * h[j][e] + xdt * Bv[e]; yp += Cv[e] * h[j][e]; } }
#pragma unroll
        for (int j = 0; j < 4; ++j) *(f32x4*)(SO + ((size_t)u * HD + p) * NST + 32 * j + 4 * q) = h[j];
        yp += __shfl_xor(yp, 1); yp += __shfl_xor(yp, 2); yp += __shfl_xor(yp, 4);
        if (q == 0) { const float y = yp + F.in[I_MD][head] * xs, zv = bf2f(Z[row * MIN + head * 64 + p]); GY[row * 3072 + 1024 + head * 64 + p] = (bf16)f2bf(y * siluf_(zv)); }
    }
}

__device__ __forceinline__ void p3_mixers(Frame& F) {
    for (int rep = 0; rep < P_SSDP; ++rep)
    for (int u = blockIdx.x; u < NBATCH * NH; u += F.G) { const int b = u >> 5, head = u & 31;
        ssd_prompt_mfma(F, b, head); }
    for (int rep = 0; rep < P_SSDS; ++rep) ssd_sample_waves(F);
    __syncthreads();
    for (int r_ = 0; r_ < P_S5P; ++r_)
    for (int u = blockIdx.x; u < G5 * 4; u += F.G) s5_prompt_mfma(F, u >> 2, u & 3);
    for (int r_ = 0; r_ < P_S5S; ++r_)
    for (int u = blockIdx.x * NWAVES + F.wave; u < MS * G5; u += F.G * NWAVES) s5_sample_unit(F, u >> 6, u & 63);
}
__device__ __forceinline__ void p5b_norm(Frame& F) {
    const float* MIX = WSP(float, WS_MIX); float* X1 = WSP(float, WS_X1); bf16* H = WSP(bf16, WS_H); const float* MOD = WSP(float, WS_MOD);
    const float* gpo = F.in[I_NPOM]; const float* gpf = F.in[I_NPF];
    for (int m = blockIdx.x * NWAVES + F.wave; m < MT; m += F.G * NWAVES) {
        const f32x4* xr = (const f32x4*)xrow(F, m) + F.lane; const f32x4* mx = (const f32x4*)(MIX + (size_t)m * DM) + F.lane; const float* mr = MOD + (size_t)modrow(m) * 6144;
        f32x4 v[4], x[4]; float s2 = 0.f;
#pragma unroll
        for (int j = 0; j < 4; ++j) { v[j] = mx[64 * j]; x[j] = xr[64 * j]; s2 += (v[j].x * v[j].x + v[j].y * v[j].y) + (v[j].z * v[j].z + v[j].w * v[j].w); }
        const float r1 = 1.0f / sqrtf(wave_sum(s2) * (1.f / DM) + EPS); float s3 = 0.f;
#pragma unroll
        for (int j = 0; j < 4; ++j) { const int c = 4 * F.lane + 256 * j; const f32x4 g = *(const f32x4*)(gpo + c), gt = *(const f32x4*)(mr + 2048 + c);
            x[j] = x[j] + gt * ((v[j] * r1) * g); *((f32x4*)(X1 + (size_t)m * DM) + F.lane + 64 * j) = x[j];
            s3 += (x[j].x * x[j].x + x[j].y * x[j].y) + (x[j].z * x[j].z + x[j].w * x[j].w); }
        const float r2 = 1.0f / sqrtf(wave_sum(s3) * (1.f / DM) + EPS);
        unsigned long long* o8 = (unsigned long long*)(H + (size_t)m * DM) + F.lane;
#pragma unroll
        for (int j = 0; j < 4; ++j) { const int c = 4 * F.lane + 256 * j; const f32x4 g = *(const f32x4*)(gpf + c), sh = *(const f32x4*)(mr + 3072 + c), sc = *(const f32x4*)(mr + 4096 + c);
            const f32x4 h = (x[j] * r2) * g * (sc + 1.0f) + sh;
            o8[64 * j] = (unsigned long long)pk2(h.x, h.y) | ((unsigned long long)pk2(h.z, h.w) << 32); }
    }
}
__device__ __forceinline__ void p8_out(Frame& F) {
    const float* FO = WSP(float, WS_FO); const float* X1 = WSP(float, WS_X1); const float* MOD = WSP(float, WS_MOD); const float* gpo = F.in[I_NPOF];
    for (int m = blockIdx.x * NWAVES + F.wave; m < MT; m += F.G * NWAVES) {
        const f32x4* fr = (const f32x4*)(FO + (size_t)m * DM) + F.lane; const f32x4* xr = (const f32x4*)(X1 + (size_t)m * DM) + F.lane; const float* mr = MOD + (size_t)modrow(m) * 6144;
        f32x4 v[4], x[4]; float s2 = 0.f;
#pragma unroll
        for (int j = 0; j < 4; ++j) { v[j] = fr[64 * j]; x[j] = xr[64 * j]; s2 += (v[j].x * v[j].x + v[j].y * v[j].y) + (v[j].z * v[j].z + v[j].w * v[j].w); }
        const float r1 = 1.0f / sqrtf(wave_sum(s2) * (1.f / DM) + EPS);
        f32x4* o = (f32x4*)(F.out + (m < MP ? O_YP + (size_t)m * DM : O_YS + (size_t)(m - MP) * DM)) + F.lane;
#pragma unroll
        for (int j = 0; j < 4; ++j) { const int c = 4 * F.lane + 256 * j; const f32x4 g = *(const f32x4*)(gpo + c), gt = *(const f32x4*)(mr + 5120 + c);
            o[64 * j] = x[j] + gt * ((v[j] * r1) * g); }
    }
}

__device__ __forceinline__ void small_tile(Frame& F, const bf16* A, int lda, const bf16* Bt, int ldb, int K, int rt, int ct, float (&v)[8]) {
    LAS float* RED = (LAS float*)F.lds;
    const int lane = F.lane, w = F.wave, r32 = lane & 31, hh = lane >> 5, kw = K >> 3;
    const bf16* ap = A + (size_t)(32 * rt + r32) * lda + w * kw + 8 * hh; const bf16* bp = Bt + (size_t)(32 * ct + r32) * ldb + w * kw + 8 * hh;
    f32x16 acc;
#pragma unroll
    for (int r = 0; r < 16; ++r) acc[r] = 0.f;
#pragma unroll 8
    for (int ks = 0; ks < (kw >> 4); ++ks) { const bf16x8 a = *(const bf16x8*)(ap + 16 * ks), bb = *(const bf16x8*)(bp + 16 * ks); acc = __builtin_amdgcn_mfma_f32_32x32x16_bf16(a, bb, acc, 0, 0, 0); }
    __syncthreads();
#pragma unroll
    for (int r = 0; r < 16; ++r) RED[(w * 32 + rowoff(r, hh)) * 33 + r32] = acc[r];
    __syncthreads();
    if (F.tid < 128) { const int row = F.tid >> 2, c8 = F.tid & 3;
#pragma unroll
        for (int e = 0; e < 8; ++e) { float sum = 0.f;
#pragma unroll
            for (int ww = 0; ww < 8; ++ww) sum += RED[(ww * 32 + row) * 33 + c8 * 8 + e];
            v[e] = sum; } }
}
template <class Epi> __device__ __forceinline__ void small_gemm(Frame& F, const bf16* A, const bf16* Bt, int K, const Epi& E) {
    for (int t = blockIdx.x; t < 128; t += F.G) { float v[8]; small_tile(F, A, K, Bt, K, K, t >> 5, t & 31, v);
        if (F.tid < 128) E.chunk(MP + 32 * (t >> 5) + (F.tid >> 2), 32 * (t & 31) + 8 * (F.tid & 3), v); }
    __syncthreads();
}
__device__ __forceinline__ void small_merge(Frame& F) {
    const bf16* GY = WSP(bf16, WS_GY) + (size_t)MP * 3072; const bf16* WB = WSP(bf16, WS_WBR); const bf16* GA = WSP(bf16, WS_GA); const bf16* GB = WSP(bf16, WS_GB); bf16* O = WSP(bf16, WS_MERGED);
    LAS float* RSs = (LAS float*)(F.lds + 40960);
    for (int t = blockIdx.x; t < 128; t += F.G) { const int rt = t >> 5, ct = t & 31;
        {   const int rr = F.tid >> 4, seg = F.tid & 15; const bf16* yp = GY + (size_t)(32 * rt + rr) * 3072 + 1024 + seg * 128; float q2 = 0.f;
#pragma unroll 4
            for (int i = 0; i < 16; ++i) { const v4u w4 = *(const v4u*)(yp + 8 * i); float f[8]; unpack8(w4, f);
                q2 += (f[0] * f[0] + f[1] * f[1]) + (f[2] * f[2] + f[3] * f[3]) + (f[4] * f[4] + f[5] * f[5]) + (f[6] * f[6] + f[7] * f[7]); }
            q2 += __shfl_xor(q2, 1); q2 += __shfl_xor(q2, 2); q2 += __shfl_xor(q2, 4); q2 += __shfl_xor(q2, 8);
            if (seg == 0) RSs[rr] = 1.0f / sqrtf(q2 * (1.f / MIN) + EPS); }
        float v1[8], v2[8];
        small_tile(F, GY, 3072, WB, 3072, 1024, rt, ct, v1);
        small_tile(F, GY + 1024, 3072, WB + 1024, 3072, 2048, rt, ct, v2);
        if (F.tid < 128) { const int lr = F.tid >> 2, row = MP + 32 * rt + lr, col0 = 32 * ct + 8 * (F.tid & 3); const size_t off = (size_t)row * 1024 + col0; const float r = RSs[lr];
            float ga[8], gb[8], o[8]; unpack8(*(const v4u*)(GA + off), ga); unpack8(*(const v4u*)(GB + off), gb);
#pragma unroll
            for (int e = 0; e < 8; ++e) o[e] = ga[e] * v1[e] + gb[e] * r * v2[e];
            v4u ow; ow.x = pk2(o[0], o[1]); ow.y = pk2(o[2], o[3]); ow.z = pk2(o[4], o[5]); ow.w = pk2(o[6], o[7]);
            *(v4u*)(O + off) = ow; }
        __syncthreads();
    }
}

constexpr int N_PHASES = 12;
__global__ void __launch_bounds__(NWAVES * 64, 2) mk_fwd(Args args) {
    extern __shared__ __attribute__((aligned(16))) unsigned char lds[];
    Frame F;
    F.lds = (LAS unsigned char*)lds; F.MISC = (volatile LAS unsigned*)(F.lds + MISC_OFF);
    F.tid = threadIdx.x; F.lane = F.tid & 63; F.wave = __builtin_amdgcn_readfirstlane(F.tid >> 6); F.G = gridDim.x;
    F.in = args.in; F.out = args.out; F.ws = args.ws; F.ctl = (gu32*)(args.ws + WS_CTL);
    if (F.tid < 32) ((LAS unsigned*)(F.lds + MISC_OFF))[F.tid] = 0u;
    __syncthreads();
    XcdBarrier bar; bar.bar = (unsigned*)(F.ctl + CW_BAR); bar.x = 0; bar.st = nullptr;
    if (MK_ONE_LAUNCH) bar = xcd_barrier_post((unsigned*)(F.ctl + CW_BAR), F.MISC + 8);
    const int lo = args.ph_lo, hi = args.ph_hi;
#define IN(k) (lo <= (k) && (k) < hi)
#define SEAM(k) do { if (IN(k) && IN((k) + 1)) xcd_barrier(bar); } while (0)
    typedef pg8::StaticOrder SO;
    if (IN(0)) { for (int r_ = 0; r_ < P_MOD; ++r_) p0_mod(F); p0_s5consts(F); for (int r_ = 0; r_ < P_TAB; ++r_) p0_s5tables(F); for (int r_ = 0; r_ < P_WCVT; ++r_) p0_weights(F); } SEAM(0);
    if (IN(1)) { for (int r_ = 0; r_ < P_NORM1; ++r_) p1_norm(F); } SEAM(1);
    for (int rg_ = 0; rg_ < P_G2; ++rg_) if (IN(2)) { pg8::Gemm g{WSP(bf16, WS_H), WSP(bf16, WS_WIN), MPAD, NPROJ, 1024}; SO S; S.init(MPAD, NPROJ, F.G, (int)blockIdx.x);
        pg8::EpiProj E{WSP(bf16, WS_U), WSP(bf16, WS_Z), WSP(bf16, WS_XBC), WSP(bf16, WS_GA), WSP(bf16, WS_GB), WSP(float, WS_DT), F.in[I_DTB]};
        pg8::gemm_phase<pg8::EpiProj, SO, true, true>(F.lds, g, S, E); } SEAM(2);
    if (IN(3)) { for (int r_ = 0; r_ < P_CONV; ++r_) p_conv(F); } SEAM(3);
    if (IN(4)) { p3_mixers(F); } SEAM(4);
    for (int rg_ = 0; rg_ < P_G6; ++rg_) if (IN(5)) { pg8::Gemm g{WSP(bf16, WS_YA), WSP(bf16, WS_WGLU), MP, 1024, 1024}; SO S; S.init(MP, 1024, F.G, (int)blockIdx.x);
        pg8::EpiGate<0> E{WSP(bf16, WS_GY), WSP(bf16, WS_YA), nullptr, F.in[I_BGLU], nullptr, 3072};
        pg8::gemm_phase<pg8::EpiGate<0>, SO, true, true>(F.lds, g, S, E); small_gemm(F, WSP(bf16, WS_YA) + (size_t)MP * 1024, WSP(bf16, WS_WGLU), 1024, E); } SEAM(5);
    for (int rg_ = 0; rg_ < P_G8; ++rg_) if (IN(6)) {
        pg8::Gemm g{WSP(bf16, WS_GY), WSP(bf16, WS_WBR), MP, 1024, 3072}; SO S; S.init(MP, 1024, F.G, (int)blockIdx.x);
        LAS float* rsl = (LAS float*)(F.lds + 131072);
        { pg8::Unit u0; if (S.next(0, u0) && F.tid < 256) { const float* q = WSP(float, WS_SSQ) + (size_t)(u0.pm * 256 + F.tid) * 32; float sum = 0.f;
#pragma unroll
                for (int j = 0; j < 8; ++j) { const f32x4 v = *(const f32x4*)(q + 4 * j); sum += (v[0] + v[1]) + (v[2] + v[3]); }
                rsl[F.tid] = 1.0f / sqrtf(sum * (1.f / MIN) + EPS); } }
        __syncthreads();
        pg8::EpiMerge E{WSP(bf16, WS_MERGED), WSP(bf16, WS_GA), WSP(bf16, WS_GB), rsl, 1024 / 64};
        pg8::gemm_phase<pg8::EpiMerge, SO, true, true>(F.lds, g, S, E); small_merge(F); } SEAM(6);
    for (int rg_ = 0; rg_ < P_G9; ++rg_) if (IN(7)) { pg8::Gemm g{WSP(bf16, WS_MERGED), WSP(bf16, WS_WOUT), MP, 1024, 1024}; SO S; S.init(MP, 1024, F.G, (int)blockIdx.x);
        pg8::EpiF32 E{WSP(float, WS_MIX)};
        pg8::gemm_phase<pg8::EpiF32, SO, true, true>(F.lds, g, S, E); small_gemm(F, WSP(bf16, WS_MERGED) + (size_t)MP * 1024, WSP(bf16, WS_WOUT), 1024, E); } SEAM(7);
    if (IN(8)) { for (int r_ = 0; r_ < P_P5B; ++r_) p5b_norm(F); } SEAM(8);
    for (int rg_ = 0; rg_ < P_G11; ++rg_) if (IN(9)) { pg8::Gemm g{WSP(bf16, WS_H), WSP(bf16, WS_WFI), MPAD, 2 * DFF, 1024}; SO S; S.init(MPAD, 2 * DFF, F.G, (int)blockIdx.x);
        pg8::EpiSwiglu E{WSP(bf16, WS_FA)};
        pg8::gemm_phase<pg8::EpiSwiglu, SO, true, true>(F.lds, g, S, E); } SEAM(9);
    for (int rg_ = 0; rg_ < P_G12; ++rg_) if (IN(10)) { pg8::Gemm g{WSP(bf16, WS_FA), WSP(bf16, WS_WFO), MP, 1024, DFF}; SO S; S.init(MP, 1024, F.G, (int)blockIdx.x);
        pg8::EpiF32 E{WSP(float, WS_FO)};
        pg8::gemm_phase<pg8::EpiF32, SO, true, true>(F.lds, g, S, E); small_gemm(F, WSP(bf16, WS_FA) + (size_t)MP * DFF, WSP(bf16, WS_WFO), DFF, E); } SEAM(10);
    if (IN(11)) { for (int r_ = 0; r_ < P_P8; ++r_) p8_out(F); }
#undef IN
#undef SEAM
}

extern "C" void kernel_launch(void* const* d_in, const int* in_sizes, int n_in, void* d_out, int out_size, void* d_ws, size_t ws_size, hipStream_t stream) {
    static int grid = 0;
    if (grid == 0) {
        if (n_in != N_IN || (size_t)out_size != O_END || ws_size < WS_END) { fprintf(stderr, "kernel_launch: unexpected shapes: n_in %d out %d ws %zu (need %zu / %zu)\n", n_in, out_size, ws_size, (size_t)O_END, (size_t)WS_END); grid = -1; return; }
        int dev = 0, cus = 0, per_cu = 0;
        if (hipGetDevice(&dev) != hipSuccess || hipDeviceGetAttribute(&cus, hipDeviceAttributeMultiprocessorCount, dev) != hipSuccess) { grid = -1; return; }
        if (hipFuncSetAttribute((const void*)mk_fwd, hipFuncAttributeMaxDynamicSharedMemorySize, LDS_BYTES) != hipSuccess) { fprintf(stderr, "kernel_launch: hipFuncSetAttribute failed\n"); grid = -1; return; }
        if (hipOccupancyMaxActiveBlocksPerMultiprocessor(&per_cu, (const void*)mk_fwd, NWAVES * 64, LDS_BYTES) != hipSuccess || per_cu < 1) { fprintf(stderr, "kernel_launch: occupancy query says %d blocks per CU\n", per_cu); per_cu = 1; }
        (void)hipGetLastError();
        if (cus != 256) { fprintf(stderr, "kernel_launch: built for a 256-CU device (one 256x256 unit per workgroup in the N = 1024 GEMM phases); found %d CUs; nothing launched\n", cus); grid = -1; return; }
        grid = cus;
    }
    if (grid < 0) return;
    (void)hipMemsetAsync((char*)d_ws + WS_CTL, 0, CTL_ZERO_BYTES, stream);
    Args a{};
    for (int i = 0; i < N_IN; ++i) a.in[i] = (const float*)d_in[i];
    a.out = (float*)d_out; a.ws = (unsigned char*)d_ws;
    if (MK_ONE_LAUNCH) { a.ph_lo = 0; a.ph_hi = N_PHASES; hipLaunchKernelGGL(mk_fwd, dim3(grid), dim3(NWAVES * 64), LDS_BYTES, stream, a); }
    else for (int p = 0; p < N_PHASES; ++p) { a.ph_lo = p; a.ph_hi = p + 1; hipLaunchKernelGGL(mk_fwd, dim3(grid), dim3(NWAVES * 64), LDS_BYTES, stream, a); }
}
```

```cpp
#include <hip/hip_runtime.h>
#include <cstdio>
#include <cstdint>
namespace pg8 {
#define PG8_LAS __attribute__((address_space(3)))
typedef unsigned short bf16_t;
typedef short bf16x8 __attribute__((ext_vector_type(8)));
typedef float f32x4 __attribute__((ext_vector_type(4)));
typedef unsigned u32x4 __attribute__((ext_vector_type(4)));
constexpr int BM = 256, BK = 64, HALF = 128, HTB = HALF * BK * 2  , STAGE_BYTES = 8 * HTB, NXCD = 8, WGM = 8;

__host__ __device__ __forceinline__ int lds_byte(int r, int c) { const int st = (r >> 4) * 2 + (c >> 5), rr = r & 15, cc = c & 31, ob = rr * 64 + cc * 2; return st * 1024 + (ob ^ (((ob >> 9) & 1) << 5)); }
__host__ __device__ __forceinline__ void stage_rc(int b, int& R, int& C) { const int st = b / 1024, sb = b % 1024, swz = sb ^ (((sb >> 9) & 1) << 5); R = (st >> 1) * 16 + swz / 64; C = (st & 1) * 32 + (swz % 64) / 2; }
__host__ __device__ __forceinline__ int perm32(int rho) { const int n = rho >> 4, i = rho & 15; return 8 * (i >> 2) + 4 * n + (i & 3); }

struct Unit { int pm, pn; };
struct Gemm { const bf16_t* A; const bf16_t* Bt; int M, N, K; };

struct StaticOrder {
    int nM, nN, nwg, G, c;
    __host__ __device__ void init(int M, int N, int G_, int c_) { nM = M / BM; nN = N / BM; nwg = nM * nN; G = G_; c = c_; }
    __host__ __device__ bool next(int i, Unit& u) const {
        const long L = (long)i * G + c; if (L >= nwg) return false;
        int wgid = (int)L; { const int q = nwg / NXCD, r = nwg % NXCD, xcd = wgid % NXCD, off = wgid / NXCD; wgid = (xcd < r ? xcd * (q + 1) : r * (q + 1) + (xcd - r) * q) + off; }
        const int nig = WGM * nN, gid = wgid / nig, fm = gid * WGM, gsz = (nM - fm) < WGM ? (nM - fm) : WGM;
        u.pm = fm + ((wgid % nig) % gsz); u.pn = (wgid % nig) / gsz; return true;
    }
    __device__ __forceinline__ void a_ready(const Unit&) const {}
    __device__ __forceinline__ void done(const Unit&) const {}
};

__device__ __forceinline__ unsigned cvt_pk_bf16(float lo, float hi) { unsigned r; asm volatile("v_cvt_pk_bf16_f32 %0, %1, %2" : "=v"(r) : "v"(lo), "v"(hi)); return r; }
typedef float f32x2 __attribute__((ext_vector_type(2)));
__device__ __forceinline__ f32x2 gelu_pk(f32x2 v) {
    const f32x2 av = __builtin_elementwise_abs(v), d = av * 0.2316418882f + 1.0f;
    f32x2 t; t.x = __builtin_amdgcn_rcpf(d.x); t.y = __builtin_amdgcn_rcpf(d.y);
    f32x2 q = t * 0.5307027145f + (-0.7265760135f); q = q * t + 0.7107068705f; q = q * t + (-0.142248368f); q = q * t + 0.127414796f; q = q * t;
    const f32x2 s = (v * v) * (-0.72134752044f);
    f32x2 e; e.x = __builtin_amdgcn_exp2f(s.x); e.y = __builtin_amdgcn_exp2f(s.y);
    const f32x2 m = v * (q * e), r = v - m;
    f32x2 o; o.x = v.x < 0.f ? m.x : r.x; o.y = v.y < 0.f ? m.y : r.y; return o;
}

template <int ACT  > struct EpiBf16 {
    static constexpr bool PERM = true, AFTER_DRAIN = false, HAS_MID = false; static_assert(ACT == 0 || ACT == 1, "EpiBf16: ACT is 0 (none) or 1 (gelu_pk)");
    bf16_t* O; int ldc; const float* bias; int split_cols; size_t split_stride; float scale0;
    __device__ __forceinline__ void operator()(const f32x4 (&acc)[2][2][4][2], const Unit& u, int wr, int wc, int fr, int fq) const {
        const int row0 = u.pm * BM + wr * 64 + fr; int colt = u.pn * BM; bf16_t* base = O;
        float sc = 1.f; if (split_cols) { const int t = colt / split_cols; base += (size_t)t * split_stride; colt -= t * split_cols; if (t == 0) sc = scale0; }
        const int col0 = colt + wc * 32 + 8 * fq, bcol0 = u.pn * BM + wc * 32 + 8 * fq;
        f32x4 bv[2][2];
#pragma unroll
        for (int bj = 0; bj < 2; ++bj)
#pragma unroll
            for (int n = 0; n < 2; ++n) bv[bj][n] = bias ? *(const f32x4*)(bias + bcol0 + bj * HALF + 4 * n) : (f32x4){0.f, 0.f, 0.f, 0.f};
#pragma unroll
        for (int ai = 0; ai < 2; ++ai)
#pragma unroll
            for (int m = 0; m < 4; ++m) { bf16_t* rowp = base + (size_t)(row0 + ai * HALF + m * 16) * ldc + col0;
#pragma unroll
                for (int bj = 0; bj < 2; ++bj) { f32x4 v0 = acc[ai][bj][m][0] + bv[bj][0], v1 = acc[ai][bj][m][1] + bv[bj][1];
                    if (ACT == 1) { f32x2 a = gelu_pk((f32x2){v0[0], v0[1]}), b = gelu_pk((f32x2){v0[2], v0[3]}), c = gelu_pk((f32x2){v1[0], v1[1]}), d = gelu_pk((f32x2){v1[2], v1[3]});
                        v0 = (f32x4){a.x, a.y, b.x, b.y}; v1 = (f32x4){c.x, c.y, d.x, d.y}; }
                    v0 = v0 * sc; v1 = v1 * sc; u32x4 w; w.x = cvt_pk_bf16(v0[0], v0[1]); w.y = cvt_pk_bf16(v0[2], v0[3]); w.z = cvt_pk_bf16(v1[0], v1[1]); w.w = cvt_pk_bf16(v1[2], v1[3]);
                    *(u32x4*)(rowp + bj * HALF) = w; } }
    }
};
template <class Epi, class Sched, bool ALIGN_EPI = false, bool SP2 = false>
__device__ __forceinline__ void gemm_phase(PG8_LAS unsigned char* lds, const Gemm g, const Sched& S, const Epi& E) {
    int tid_ = threadIdx.x; asm volatile("" : "+v"(tid_));
    const int tid = tid_, wid = __builtin_amdgcn_readfirstlane(tid >> 6), lane = tid & 63, wr = wid >> 2, wc = wid & 3, fr = lane & 15, fq = lane >> 4;
    const int K = g.K, nt = K / BK;
    unsigned voffA[2], voffB[2];
#pragma unroll
    for (int i = 0; i < 2; ++i) { int R, C; stage_rc(tid * 16 + i * 8192, R, C); const int Rb = Epi::PERM ? ((R & ~31) + perm32(R & 31)) : R;
        voffA[i] = (unsigned)(R * K + C) * 2u; voffB[i] = (unsigned)(Rb * K + C) * 2u; }
    const size_t kstep = (size_t)(BK * 2);
    const size_t hstep = (size_t)HALF * K * 2;
    const size_t tstep = 2 * hstep;
    const unsigned ldsw = (unsigned)wid * 1024u;
    const int aoff = lds_byte(wr * 64 + fr, fq * 8), boff = lds_byte(wc * 32 + fr, fq * 8);
#define PG8_SA(b, h) (((b) * 2 + (h)) * HTB)
#define PG8_SB(b, h) ((4 + (b) * 2 + (h)) * HTB)
#define PG8_STAGE(bufoff, gbase, voff) do { _Pragma("unroll") for (int _i = 0; _i < 2; ++_i) \
        __builtin_amdgcn_global_load_lds((const unsigned*)((const char*)(gbase) + (voff)[_i]), (PG8_LAS unsigned*)(lds + (bufoff) + ldsw + _i * 8192), 16, 0, 0); } while (0)
#define PG8_LDA(dst, b, h) do { _Pragma("unroll") for (int m = 0; m < 4; ++m) _Pragma("unroll") for (int k = 0; k < 2; ++k) dst[m][k] = *(const PG8_LAS bf16x8*)(lds + PG8_SA(b, h) + aoff + m * 2048 + k * 1024); } while (0)
#define PG8_LDB(dst, b, h) do { _Pragma("unroll") for (int n = 0; n < 2; ++n) _Pragma("unroll") for (int k = 0; k < 2; ++k) dst[n][k] = *(const PG8_LAS bf16x8*)(lds + PG8_SB(b, h) + boff + n * 2048 + k * 1024); } while (0)
#define PG8_MMA(ai, bj, At, Bt) do { __builtin_amdgcn_s_setprio(1); _Pragma("unroll") for (int m = 0; m < 4; ++m) _Pragma("unroll") for (int n = 0; n < 2; ++n) _Pragma("unroll") for (int k = 0; k < 2; ++k) \
        acc[ai][bj][m][n] = __builtin_amdgcn_mfma_f32_16x16x32_bf16(Bt[n][k], At[m][k], acc[ai][bj][m][n], 0, 0, 0); __builtin_amdgcn_s_setprio(0); } while (0)
#define PG8_WAIT_V(n) asm volatile("s_waitcnt vmcnt(" #n ")" ::: "memory")
#define PG8_WAIT_L(n) asm volatile("s_waitcnt lgkmcnt(" #n ")" ::: "memory")
#define PG8_BAR __builtin_amdgcn_s_barrier()
#define PG8_SCHED __builtin_amdgcn_sched_barrier(0)
    Unit cur, nxt; int ui = 0;
    if (!S.next(0, cur)) return;
    f32x4 acc[2][2][4][2];
#pragma unroll
    for (int a = 0; a < 2; ++a)
#pragma unroll
        for (int b = 0; b < 2; ++b)
#pragma unroll
            for (int m = 0; m < 4; ++m)
#pragma unroll
                for (int n = 0; n < 2; ++n) acc[a][b][m][n] = (f32x4){0.f, 0.f, 0.f, 0.f};
    bf16x8 At[4][2], B0[2][2], B1[2][2];
    const char* cA = (const char*)g.A + (size_t)cur.pm * tstep; const char* cB = (const char*)g.Bt + (size_t)cur.pn * tstep;
    S.a_ready(cur);
    if constexpr (SP2) {
        PG8_STAGE(PG8_SB(0, 0), cB, voffB); PG8_STAGE(PG8_SB(0, 1), cB + hstep, voffB); PG8_STAGE(PG8_SA(0, 0), cA, voffA); PG8_STAGE(PG8_SA(0, 1), cA + hstep, voffA);
        if (wr == 1) PG8_BAR;
        PG8_WAIT_V(2); PG8_BAR;
        PG8_STAGE(PG8_SB(1, 0), cB + kstep, voffB); PG8_STAGE(PG8_SA(1, 0), cA + kstep, voffA); PG8_STAGE(PG8_SB(1, 1), cB + hstep + kstep, voffB);
        PG8_WAIT_V(6); PG8_BAR;
    } else {
        PG8_STAGE(PG8_SB(0, 0), cB, voffB); PG8_STAGE(PG8_SA(0, 0), cA, voffA); PG8_STAGE(PG8_SB(0, 1), cB + hstep, voffB); PG8_STAGE(PG8_SA(0, 1), cA + hstep, voffA);
        if (wr == 1) PG8_BAR;
        PG8_WAIT_V(4); PG8_BAR;
        PG8_STAGE(PG8_SB(1, 0), cB + kstep, voffB); PG8_STAGE(PG8_SA(1, 0), cA + kstep, voffA); PG8_STAGE(PG8_SB(1, 1), cB + hstep + kstep, voffB);
        PG8_WAIT_V(6); PG8_BAR;
    }
    for (;;) {
        const bool has_next = S.next(ui + 1, nxt);
        const char* nA = has_next ? (const char*)g.A + (size_t)nxt.pm * tstep : cA; const char* nB = has_next ? (const char*)g.Bt + (size_t)nxt.pn * tstep : cB;
        for (int seg = 0; seg < (Epi::HAS_MID ? 2 : 1); ++seg) {
        int tb = 0, te = nt; if constexpr (Epi::HAS_MID) { tb = seg ? E.mid_t : 0; te = seg ? nt : E.mid_t; }
        for (int t = tb; t < te; t += 2) {
            const bool last = (t == nt - 2);
            const char* a1 = cA + (size_t)(t + 1) * kstep;
            const char* a2 = last ? nA : cA + (size_t)(t + 2) * kstep; const char* b2 = last ? nB : cB + (size_t)(t + 2) * kstep;
            const char* a3 = a2 + kstep; const char* b3 = b2 + kstep;
            if (last && has_next) S.a_ready(nxt);
            if constexpr (SP2) {
            PG8_LDB(B0, 0, 0); PG8_LDB(B1, 0, 1); PG8_SCHED; PG8_LDA(At, 0, 0); PG8_STAGE(PG8_SA(1, 1), a1 + hstep, voffA);
            PG8_WAIT_V(8); PG8_WAIT_L(0); PG8_BAR; PG8_MMA(0, 0, At, B0); PG8_MMA(0, 1, At, B1); PG8_BAR; PG8_SCHED;
            PG8_LDA(At, 0, 1); PG8_STAGE(PG8_SB(0, 0), b2, voffB); PG8_STAGE(PG8_SB(0, 1), b2 + hstep, voffB); PG8_STAGE(PG8_SA(0, 0), a2, voffA);
            PG8_WAIT_V(8); PG8_WAIT_L(0); PG8_BAR; PG8_MMA(1, 0, At, B0); PG8_MMA(1, 1, At, B1); PG8_BAR; PG8_SCHED;
            PG8_LDB(B0, 1, 0); PG8_LDB(B1, 1, 1); PG8_SCHED; PG8_LDA(At, 1, 0); PG8_STAGE(PG8_SA(0, 1), a2 + hstep, voffA);
            PG8_WAIT_V(8); PG8_WAIT_L(0); PG8_BAR; PG8_MMA(0, 0, At, B0); PG8_MMA(0, 1, At, B1); PG8_BAR; PG8_SCHED;
            PG8_LDA(At, 1, 1); PG8_STAGE(PG8_SB(1, 0), b3, voffB); PG8_STAGE(PG8_SB(1, 1), b3 + hstep, voffB); PG8_STAGE(PG8_SA(1, 0), a3, voffA);
            PG8_WAIT_V(8); PG8_WAIT_L(0); PG8_BAR; PG8_MMA(1, 0, At, B0); PG8_MMA(1, 1, At, B1); PG8_BAR; PG8_SCHED;
            } else {
            PG8_LDB(B0, 0, 0); PG8_SCHED; PG8_LDA(At, 0, 0); PG8_STAGE(PG8_SA(1, 1), a1 + hstep, voffA);
            PG8_WAIT_L(8); PG8_BAR; PG8_WAIT_L(0); PG8_MMA(0, 0, At, B0); PG8_BAR; PG8_SCHED;
            PG8_LDB(B1, 0, 1); PG8_STAGE(PG8_SB(0, 0), b2, voffB);
            PG8_BAR; PG8_WAIT_L(0); PG8_MMA(0, 1, At, B1); PG8_BAR;
            PG8_LDA(At, 0, 1); PG8_STAGE(PG8_SA(0, 0), a2, voffA);
            PG8_BAR; PG8_WAIT_L(0); PG8_MMA(1, 0, At, B0); PG8_BAR; PG8_SCHED;
            PG8_STAGE(PG8_SB(0, 1), b2 + hstep, voffB);
            PG8_WAIT_V(6); PG8_BAR; PG8_MMA(1, 1, At, B1); PG8_BAR;
            PG8_LDB(B0, 1, 0); PG8_SCHED; PG8_LDA(At, 1, 0); PG8_STAGE(PG8_SA(0, 1), a2 + hstep, voffA);
            PG8_WAIT_L(8); PG8_BAR; PG8_WAIT_L(0); PG8_MMA(0, 0, At, B0); PG8_BAR; PG8_SCHED;
            PG8_LDB(B1, 1, 1); PG8_STAGE(PG8_SB(1, 0), b3, voffB);
            PG8_BAR; PG8_WAIT_L(0); PG8_MMA(0, 1, At, B1); PG8_BAR;
            PG8_LDA(At, 1, 1); PG8_STAGE(PG8_SA(1, 0), a3, voffA);
            PG8_BAR; PG8_WAIT_L(0); PG8_MMA(1, 0, At, B0); PG8_BAR; PG8_SCHED;
            PG8_STAGE(PG8_SB(1, 1), b3 + hstep, voffB);
            PG8_WAIT_V(6); PG8_BAR; PG8_MMA(1, 1, At, B1); PG8_BAR;
            }
        }
        if constexpr (Epi::HAS_MID) { if (seg == 0) E.mid(acc, cur, wr, wc, fr, fq); }
        }
        if constexpr (ALIGN_EPI) { if (wr == 0) PG8_BAR; }
        if constexpr (!Epi::AFTER_DRAIN) { E(acc, cur, wr, wc, fr, fq); S.done(cur); }
        if (!has_next) break;
#pragma unroll
        for (int a = 0; a < 2; ++a)
#pragma unroll
            for (int b = 0; b < 2; ++b)
#pragma unroll
                for (int m = 0; m < 4; ++m)
#pragma unroll
                    for (int n = 0; n < 2; ++n) acc[a][b][m][n] = (f32x4){0.f, 0.f, 0.f, 0.f};
        cur = nxt; cA = nA; cB = nB; ++ui;
        if constexpr (ALIGN_EPI) { if (wr == 1) PG8_BAR; }
    }
    PG8_WAIT_V(0);
    if constexpr (!ALIGN_EPI) { if (wr == 0) PG8_BAR; }
    PG8_BAR;
    if constexpr (Epi::AFTER_DRAIN) { E.fused(acc, cur, wr, wc, fr, fq, lds, wid, lane); S.done(cur); }
#undef PG8_SA
#undef PG8_SB
#undef PG8_STAGE
#undef PG8_LDA
#undef PG8_LDB
#undef PG8_MMA
#undef PG8_WAIT_V
#undef PG8_WAIT_L
#undef PG8_BAR
#undef PG8_SCHED
}
}

#define GAS __attribute__((address_space(1)))
#define LAS __attribute__((address_space(3)))
typedef unsigned short bf16;
typedef unsigned v4u __attribute__((ext_vector_type(4)));
typedef unsigned v2u __attribute__((ext_vector_type(2)));
typedef float f32x4 __attribute__((ext_vector_type(4)));
typedef short bf16x8 __attribute__((ext_vector_type(8)));
typedef GAS unsigned gu32;
#define RLX_AGENT __ATOMIC_RELAXED, __HIP_MEMORY_SCOPE_AGENT
#define LDS_WAIT() asm volatile("s_waitcnt lgkmcnt(0)" ::: "memory")
#define VM_WAIT() asm volatile("s_waitcnt vmcnt(0)" ::: "memory")
__device__ __forceinline__ unsigned f2bf(float f) { unsigned u = __builtin_bit_cast(unsigned, f); return (u + 0x7fffu + ((u >> 16) & 1u)) >> 16; }
__device__ __forceinline__ unsigned pk2(float lo, float hi) { return pg8::cvt_pk_bf16(lo, hi); }
__device__ __forceinline__ float bflo(unsigned w) { return __uint_as_float(w << 16); }
__device__ __forceinline__ float bfhi(unsigned w) { return __uint_as_float(w & 0xffff0000u); }
__device__ __forceinline__ float bf2f(bf16 h) { return __uint_as_float((unsigned)h << 16); }
__device__ __forceinline__ float sigmoidf_(float x) { return __builtin_amdgcn_rcpf(1.0f + __expf(-x)); }
__device__ __forceinline__ float siluf_(float x) { return x * __builtin_amdgcn_rcpf(1.0f + __expf(-x)); }
__device__ __forceinline__ float softplusf_(float x) { return fmaxf(x, 0.f) + log1pf(__expf(-fabsf(x))); }
__device__ __forceinline__ float gelu_tanh(float y) { const float z = 0.7978845608028654f * (y + 0.044715f * y * y * y); const float t = 1.0f - 2.0f * __builtin_amdgcn_rcpf(1.0f + __expf(2.0f * z)); return 0.5f * y * (1.0f + t); }
__device__ __forceinline__ float wave_sum(float v) {
#pragma unroll
    for (int o = 1; o < 64; o <<= 1) v += __shfl_xor(v, o);
    return v;
}
#define XB_TMO      128
#define XB_XCNT(j)  (256  + 64 * (j))
#define XB_XSUB(j)  (1280 + 64 * (j))
#define XB_XGEN(j)  (2304 + 64 * (j))
#define XB_TOP      3328
#define XB_TOPGEN   3392
#define XCD_BAR_WORDS 3456
#define XB_SPIN_CAP (1u << 18)

__device__ __forceinline__ unsigned xb_ld(unsigned* p)              { return __hip_atomic_load(p, __ATOMIC_RELAXED, __HIP_MEMORY_SCOPE_AGENT); }
__device__ __forceinline__ unsigned xb_add(unsigned* p, unsigned v) { return __hip_atomic_fetch_add(p, v, __ATOMIC_RELAXED, __HIP_MEMORY_SCOPE_AGENT); }
__device__ __forceinline__ unsigned xb_xcc_id() { return (unsigned)__builtin_amdgcn_s_getreg((3 << 11) | 20) & 0xFu; }
#define XB_SPIN(cond, bar) do { unsigned _sp = 0; while (cond) { __builtin_amdgcn_s_sleep(1); \
    if ((++_sp & 255u) == 0u) { if (xb_ld(&(bar)[XB_TMO])) break; if (_sp > XB_SPIN_CAP) { atomicAdd(&(bar)[XB_TMO], 1u); break; } } } } while (0)

struct XcdBarrier {
    unsigned* bar; unsigned x;
    volatile LAS unsigned* st;
};

__device__ __forceinline__ XcdBarrier xcd_barrier_post(unsigned* bar, volatile LAS unsigned* st) {
    XcdBarrier b; b.bar = bar; b.x = xb_xcc_id(); b.st = st;
    if (threadIdx.x == 0) (void)xb_add(&bar[XB_XCNT(b.x)], 1u);
    return b;
}
__device__ __forceinline__ void xcd_barrier_complete(unsigned* bar, unsigned x, unsigned& nloc, unsigned& nx) {
    const unsigned G = gridDim.x * gridDim.y * gridDim.z;
    unsigned sum, cnt, mine, sp = 0u;
    for (;;) {
        sum = 0u; cnt = 0u; mine = 0u;
#pragma unroll
        for (unsigned j = 0; j < 16; ++j) { const unsigned c = xb_ld(&bar[XB_XCNT(j)]); sum += c; cnt += (c > 0u) ? 1u : 0u; mine = (j == x) ? c : mine; }
        if (sum == G) break;
        __builtin_amdgcn_s_sleep(1);
        if ((++sp & 255u) == 0u) { if (xb_ld(&bar[XB_TMO])) break; if (sp > XB_SPIN_CAP) { atomicAdd(&bar[XB_TMO], 1u); break; } }
    }
    nloc = mine > 0u ? mine : 1u; nx = cnt > 0u ? cnt : 1u;
}

__device__ __forceinline__ void xcd_barrier(const XcdBarrier& b) {
    asm volatile("s_waitcnt vmcnt(0)" ::: "memory");
    __syncthreads();
    if (threadIdx.x == 0) {
        unsigned* bar = b.bar;
        __builtin_amdgcn_s_waitcnt(0);
        unsigned nloc = b.st[0], nx = b.st[1];
        if (nloc == 0u) { xcd_barrier_complete(bar, b.x, nloc, nx); b.st[0] = nloc; b.st[1] = nx; }
        const unsigned old = xb_add(&bar[XB_XSUB(b.x)], 1u);
        const unsigned gen = old / nloc;
        if (old + 1u == (gen + 1u) * nloc) {
            __builtin_amdgcn_fence(__ATOMIC_RELEASE, "agent");
            asm volatile("s_waitcnt vmcnt(0)" ::: "memory");
            const unsigned og = xb_add(&bar[XB_TOP], 1u);
            const unsigned tg = og / nx;
            if (og + 1u == (tg + 1u) * nx) xb_add(&bar[XB_TOPGEN], 1u);
            else XB_SPIN(xb_ld(&bar[XB_TOPGEN]) == tg, bar);
            __builtin_amdgcn_fence(__ATOMIC_ACQUIRE, "agent");
            xb_add(&bar[XB_XGEN(b.x)], 1u);
            asm volatile("s_waitcnt vmcnt(0)" ::: "memory");
        } else {
            XB_SPIN(xb_ld(&bar[XB_XGEN(b.x)]) == gen, bar);
            __builtin_amdgcn_fence(__ATOMIC_ACQUIRE, "agent");
            asm volatile("s_waitcnt vmcnt(0)" ::: "memory");
        }
    }
    __syncthreads();
}

constexpr int NWAVES = 8;
#ifndef P_MOD
#define P_MOD 1
#endif
#ifndef P_TAB
#define P_TAB 1
#endif
#ifndef P_WCVT
#define P_WCVT 1
#endif
#ifndef P_NORM1
#define P_NORM1 1
#endif
#ifndef P_CONV
#define P_CONV 1
#endif
#ifndef P_S5S
#define P_S5S 1
#endif
#ifndef P_RS
#define P_RS 1
#endif
#ifndef P_P5B
#define P_P5B 1
#endif
#ifndef P_P8
#define P_P8 1
#endif
#ifndef P_SSDP
#define P_SSDP 1
#endif
#ifndef P_S5P
#define P_S5P 1
#endif
#ifndef P_SSDS
#define P_SSDS 1
#endif
#ifndef P_G2
#define P_G2 1
#endif
#ifndef P_G6
#define P_G6 1
#endif
#ifndef P_G7
#define P_G7 1
#endif
#ifndef P_G8
#define P_G8 1
#endif
#ifndef P_G9
#define P_G9 1
#endif
#ifndef P_G11
#define P_G11 1
#endif
#ifndef P_G12
#define P_G12 1
#endif
#ifndef REP_SSDP
#define REP_SSDP 1
#endif
#ifndef REP_SSDS
#define REP_SSDS 1
#endif
#ifndef REP_S5P
#define REP_S5P 1
#endif
#ifndef REP_GEMM
#define REP_GEMM 1
#endif
#ifndef MK_ONE_LAUNCH
#define MK_ONE_LAUNCH 1
#endif
constexpr int DM = 1024, NBATCH = 8, SEQ = 2048, MP = NBATCH * SEQ, MS = 128, MT = MP + MS, MPAD = 16640, NMOD = NBATCH + MS;
constexpr int G5 = 64, N5 = 64, H5 = 16;
constexpr int MIN = 2048, HD = 64, NH = 32, NG = 4, NST = 128, CDIM = 3072;
constexpr int DFF = 2816, NPROJ = 8448;
constexpr float EPS = 1e-6f;
enum { I_XP = 0, I_XS, I_S5RE, I_S5IM, I_SSM, I_CONV, I_CP, I_CS, I_WADA, I_BADA, I_NPM, I_NPOM, I_NPF, I_NPOF, I_WIN, I_LRE, I_LIM, I_LDT, I_BRE, I_BIM, I_CRE, I_CIM, I_S5D,
       I_WGLU, I_BGLU, I_CW, I_CB, I_DTB, I_ALOG, I_MD, I_MNORM, I_WBS5, I_WBSSD, I_WOUT, I_WFI, I_WFO, N_IN };
constexpr size_t O_YP = 0, O_YS = O_YP + (size_t)MP * DM, O_S5RP = O_YS + (size_t)MS * DM, O_S5IP = O_S5RP + NBATCH * G5 * N5, O_SSMP = O_S5IP + NBATCH * G5 * N5,
                 O_CONVP = O_SSMP + (size_t)NBATCH * NH * HD * NST, O_S5RS = O_CONVP + NBATCH * 3 * CDIM, O_S5IS = O_S5RS + MS * G5 * N5, O_SSMS = O_S5IS + MS * G5 * N5,
                 O_CONVS = O_SSMS + (size_t)MS * NH * HD * NST, O_END = O_CONVS + (size_t)MS * 3 * CDIM;

constexpr size_t MiB = 1u << 20;
constexpr size_t WS_CTL = 0, CTL_ZERO_BYTES = 1 * MiB;
constexpr size_t WS_MOD = 1 * MiB;
constexpr size_t WS_DT = 5 * MiB;
constexpr size_t WS_RS = 8 * MiB;
constexpr size_t WS_ABAR = 9 * MiB;
constexpr size_t WS_BBAR = 9 * MiB + 64 * 1024;
constexpr size_t WS_WIN = 16 * MiB, WS_WGLU = 33 * MiB, WS_WBR = 35 * MiB  , WS_WOUT = 41 * MiB, WS_WFI = 43 * MiB, WS_WFO = 54 * MiB;
constexpr size_t WS_H = 64 * MiB;
constexpr size_t WS_GA = 97 * MiB, WS_GB = 130 * MiB;
constexpr size_t WS_U = 163 * MiB;
constexpr size_t WS_Z = 196 * MiB;
constexpr size_t WS_XBC = 261 * MiB;
constexpr size_t WS_ACT = 359 * MiB;
constexpr size_t WS_YA = 457 * MiB;
constexpr size_t WS_GY = 261 * MiB;
constexpr size_t WS_SSQ = 10 * MiB;
constexpr size_t WS_MERGED = 359 * MiB;
constexpr size_t WS_MIX = 392 * MiB;
constexpr size_t WS_X1 = 196 * MiB;
constexpr size_t WS_FA = 261 * MiB;
constexpr size_t WS_FO = 359 * MiB;
constexpr size_t WS_A32 = 9 * MiB + 32 * 1024;
constexpr size_t WS_KT = 490 * MiB;
constexpr size_t WS_SMF = 492 * MiB;
constexpr size_t WS_OMF = 500 * MiB;
constexpr size_t WS_END = 508 * MiB;
constexpr int CW_BAR = 4096;
constexpr int LDS_BYTES = 147456;
constexpr int MISC_OFF = LDS_BYTES - 128;

struct Args { const float* in[N_IN]; float* out; unsigned char* ws; int ph_lo, ph_hi; };

namespace pg8 {
struct EpiProj {
    static constexpr bool PERM = true, AFTER_DRAIN = false, HAS_MID = false;
    bf16_t *U, *Z, *XBC, *GA, *GB; float* DT; const float* dt_bias;
    __device__ __forceinline__ void operator()(const f32x4 (&acc)[2][2][4][2], const Unit& u, int wr, int wc, int fr, int fq) const {
        const int row0 = u.pm * BM + wr * 64 + fr, pn = u.pn;
        if (pn < 32) {
            bf16_t* base; int ld, colt; bool sg = false;
            if (pn < 4) { base = U; ld = 1024; colt = pn * 256; } else if (pn < 12) { base = Z; ld = 2048; colt = (pn - 4) * 256; } else if (pn < 24) { base = XBC; ld = 3072; colt = (pn - 12) * 256; }
            else if (pn < 28) { base = GA; ld = 1024; colt = (pn - 24) * 256; sg = true; } else { base = GB; ld = 1024; colt = (pn - 28) * 256; sg = true; }
            const int col0 = colt + wc * 32 + 8 * fq;
#pragma unroll
            for (int ai = 0; ai < 2; ++ai)
#pragma unroll
                for (int m = 0; m < 4; ++m) { bf16_t* rowp = base + (size_t)(row0 + ai * HALF + m * 16) * ld + col0;
#pragma unroll
                    for (int bj = 0; bj < 2; ++bj) { f32x4 v0 = acc[ai][bj][m][0], v1 = acc[ai][bj][m][1];
                        if (sg) {
#pragma unroll
                            for (int e = 0; e < 4; ++e) { v0[e] = sigmoidf_(v0[e]); v1[e] = sigmoidf_(v1[e]); } }
                        u32x4 w; w.x = cvt_pk_bf16(v0[0], v0[1]); w.y = cvt_pk_bf16(v0[2], v0[3]); w.z = cvt_pk_bf16(v1[0], v1[1]); w.w = cvt_pk_bf16(v1[2], v1[3]);
                        *(u32x4*)(rowp + bj * HALF) = w; } }
        } else if (wc == 0) {
            const int c0 = 8 * fq;
            const f32x4 b0 = *(const f32x4*)(dt_bias + c0), b1 = *(const f32x4*)(dt_bias + c0 + 4);
#pragma unroll
            for (int ai = 0; ai < 2; ++ai)
#pragma unroll
                for (int m = 0; m < 4; ++m) { float* rowp = DT + (size_t)(row0 + ai * HALF + m * 16) * 32 + c0; f32x4 v0 = acc[ai][0][m][0] + b0, v1 = acc[ai][0][m][1] + b1;
#pragma unroll
                    for (int e = 0; e < 4; ++e) { v0[e] = softplusf_(v0[e]); v1[e] = softplusf_(v1[e]); }
                    *(f32x4*)rowp = v0; *(f32x4*)(rowp + 4) = v1; }
        }
    }
};
template <int MODE> struct EpiGate {
    static constexpr bool PERM = true, AFTER_DRAIN = false, HAS_MID = false;
    bf16_t* O; const bf16_t* X; const bf16_t* Y; const float* bias; const float* rs; int ldo;
    __device__ __forceinline__ void chunk(int row, int col0, const float (&av)[8]) const {
        const size_t off = (size_t)row * 1024 + col0;
        const u32x4 xw = *(const u32x4*)(X + off);
        const float xv[8] = {bflo(xw.x), bfhi(xw.x), bflo(xw.y), bfhi(xw.y), bflo(xw.z), bfhi(xw.z), bflo(xw.w), bfhi(xw.w)}; float o[8];
        if (MODE == 0) { const f32x4 b0 = *(const f32x4*)(bias + col0), b1 = *(const f32x4*)(bias + col0 + 4); const float bv[8] = {b0[0], b0[1], b0[2], b0[3], b1[0], b1[1], b1[2], b1[3]};
#pragma unroll
            for (int e = 0; e < 8; ++e) o[e] = xv[e] * sigmoidf_(av[e] + bv[e]);
        } else if (MODE == 1) {
#pragma unroll
            for (int e = 0; e < 8; ++e) o[e] = xv[e] * av[e];
        } else { const float r = rs[row]; const u32x4 yw = *(const u32x4*)(Y + off);
            const float yv[8] = {bflo(yw.x), bfhi(yw.x), bflo(yw.y), bfhi(yw.y), bflo(yw.z), bfhi(yw.z), bflo(yw.w), bfhi(yw.w)};
#pragma unroll
            for (int e = 0; e < 8; ++e) o[e] = yv[e] + xv[e] * r * av[e]; }
        u32x4 w; w.x = cvt_pk_bf16(o[0], o[1]); w.y = cvt_pk_bf16(o[2], o[3]); w.z = cvt_pk_bf16(o[4], o[5]); w.w = cvt_pk_bf16(o[6], o[7]);
        *(u32x4*)(O + (size_t)row * ldo + col0) = w;
    }
    __device__ __forceinline__ void operator()(const f32x4 (&acc)[2][2][4][2], const Unit& u, int wr, int wc, int fr, int fq) const {
        const int row0 = u.pm * BM + wr * 64 + fr, col0 = u.pn * BM + wc * 32 + 8 * fq;
#pragma unroll
        for (int ai = 0; ai < 2; ++ai)
#pragma unroll
            for (int m = 0; m < 4; ++m)
#pragma unroll
                for (int bj = 0; bj < 2; ++bj) { const f32x4 a0 = acc[ai][bj][m][0], a1 = acc[ai][bj][m][1]; const float av[8] = {a0[0], a0[1], a0[2], a0[3], a1[0], a1[1], a1[2], a1[3]};
                    chunk(row0 + ai * HALF + m * 16, col0 + bj * HALF, av); }
    }
};
struct EpiF32 {
    static constexpr bool PERM = true, AFTER_DRAIN = false, HAS_MID = false;
    float* C;
    __device__ __forceinline__ void chunk(int row, int col0, const float (&av)[8]) const {
        float* p = C + (size_t)row * 1024 + col0; *(f32x4*)p = (f32x4){av[0], av[1], av[2], av[3]}; *(f32x4*)(p + 4) = (f32x4){av[4], av[5], av[6], av[7]}; }
    __device__ __forceinline__ void operator()(const f32x4 (&acc)[2][2][4][2], const Unit& u, int wr, int wc, int fr, int fq) const {
        const int row0 = u.pm * BM + wr * 64 + fr, col0 = u.pn * BM + wc * 32 + 8 * fq;
#pragma unroll
        for (int ai = 0; ai < 2; ++ai)
#pragma unroll
            for (int m = 0; m < 4; ++m)
#pragma unroll
                for (int bj = 0; bj < 2; ++bj) { const f32x4 a0 = acc[ai][bj][m][0], a1 = acc[ai][bj][m][1]; const float av[8] = {a0[0], a0[1], a0[2], a0[3], a1[0], a1[1], a1[2], a1[3]};
                    chunk(row0 + ai * HALF + m * 16, col0 + bj * HALF, av); }
    }
};
struct EpiMerge {
    static constexpr bool PERM = true, AFTER_DRAIN = false, HAS_MID = true;
    bf16_t* O; const bf16_t* GA; const bf16_t* GB; const PG8_LAS float* rsl; int mid_t;
    __device__ __forceinline__ void mid(f32x4 (&acc)[2][2][4][2], const Unit& u, int wr, int wc, int fr, int fq) const {
        int lr0 = wr * 64 + fr, col0 = u.pn * BM + wc * 32 + 8 * fq; asm volatile("" : "+v"(lr0), "+v"(col0));
#pragma unroll
        for (int ai = 0; ai < 2; ++ai)
#pragma unroll
            for (int m = 0; m < 4; ++m) { const int lr = lr0 + ai * HALF + m * 16; const float r = rsl[lr]; const size_t off = (size_t)(u.pm * BM + lr) * 1024 + col0;
#pragma unroll
                for (int bj = 0; bj < 2; ++bj) { const u32x4 aw = *(const u32x4*)(GA + off + bj * HALF), bw = *(const u32x4*)(GB + off + bj * HALF);
                    const float ga[8] = {bflo(aw.x), bfhi(aw.x), bflo(aw.y), bfhi(aw.y), bflo(aw.z), bfhi(aw.z), bflo(aw.w), bfhi(aw.w)};
                    const float gb[8] = {bflo(bw.x), bfhi(bw.x), bflo(bw.y), bfhi(bw.y), bflo(bw.z), bfhi(bw.z), bflo(bw.w), bfhi(bw.w)};
#pragma unroll
                    for (int e = 0; e < 4; ++e) { acc[ai][bj][m][0][e] *= ga[e] * __builtin_amdgcn_rcpf(fmaxf(gb[e], 1e-18f) * r); acc[ai][bj][m][1][e] *= ga[4 + e] * __builtin_amdgcn_rcpf(fmaxf(gb[4 + e], 1e-18f) * r); } }
                asm volatile("" ::: "memory"); }
    }
    __device__ __forceinline__ void operator()(const f32x4 (&acc)[2][2][4][2], const Unit& u, int wr, int wc, int fr, int fq) const {
        int lr0 = wr * 64 + fr, col0 = u.pn * BM + wc * 32 + 8 * fq; asm volatile("" : "+v"(lr0), "+v"(col0));
#pragma unroll
        for (int ai = 0; ai < 2; ++ai)
#pragma unroll
            for (int m = 0; m < 4; ++m) { const int lr = lr0 + ai * HALF + m * 16; const float r = rsl[lr]; const size_t off = (size_t)(u.pm * BM + lr) * 1024 + col0;
#pragma unroll
                for (int bj = 0; bj < 2; ++bj) { const u32x4 bw = *(const u32x4*)(GB + off + bj * HALF);
                    const float gb[8] = {bflo(bw.x), bfhi(bw.x), bflo(bw.y), bfhi(bw.y), bflo(bw.z), bfhi(bw.z), bflo(bw.w), bfhi(bw.w)}; float o[8];
#pragma unroll
                    for (int e = 0; e < 4; ++e) { o[e] = acc[ai][bj][m][0][e] * (fmaxf(gb[e], 1e-18f) * r); o[4 + e] = acc[ai][bj][m][1][e] * (fmaxf(gb[4 + e], 1e-18f) * r); }
                    u32x4 w; w.x = cvt_pk_bf16(o[0], o[1]); w.y = cvt_pk_bf16(o[2], o[3]); w.z = cvt_pk_bf16(o[4], o[5]); w.w = cvt_pk_bf16(o[6], o[7]);
                    *(u32x4*)(O + off + bj * HALF) = w; }
                asm volatile("" ::: "memory"); }
    }
};
struct EpiSwiglu {
    static constexpr bool PERM = true, AFTER_DRAIN = false, HAS_MID = false;
    bf16_t* O;
    __device__ __forceinline__ void operator()(const f32x4 (&acc)[2][2][4][2], const Unit& u, int wr, int wc, int fr, int fq) const {
        const int row0 = u.pm * BM + wr * 64 + fr, col0 = u.pn * HALF + wc * 32 + 8 * fq;
#pragma unroll
        for (int ai = 0; ai < 2; ++ai)
#pragma unroll
            for (int m = 0; m < 4; ++m) { bf16_t* rowp = O + (size_t)(row0 + ai * HALF + m * 16) * 2816 + col0;
                const f32x4 g0 = acc[ai][0][m][0], g1 = acc[ai][0][m][1], u0 = acc[ai][1][m][0], u1 = acc[ai][1][m][1];
                float o[8];
#pragma unroll
                for (int e = 0; e < 4; ++e) { o[e] = siluf_(g0[e]) * u0[e]; o[4 + e] = siluf_(g1[e]) * u1[e]; }
                u32x4 w; w.x = cvt_pk_bf16(o[0], o[1]); w.y = cvt_pk_bf16(o[2], o[3]); w.z = cvt_pk_bf16(o[4], o[5]); w.w = cvt_pk_bf16(o[6], o[7]);
                *(u32x4*)rowp = w; }
    }
};
}

typedef float f32x16 __attribute__((ext_vector_type(16)));
__device__ __forceinline__ int rowoff(int r, int h) { return (r & 3) + 8 * (r >> 2) + 4 * h; }
struct Frame {
    LAS unsigned char* lds;
    volatile LAS unsigned* MISC;
    gu32* ctl;
    int tid, lane, wave, G;
    const float* const* in; float* out; unsigned char* ws;
};
#define WSP(T, off) ((T*)(F.ws + (off)))

__device__ __forceinline__ void cvt_item(const float* W, int K  , int Nsrc, bf16* WT, int n0dst, int srccol0, int k0, const float* kscale, LAS float* scr, int lane, int kd0 = 0) {
#pragma unroll 8
    for (int i = 0; i < 32; ++i) { const int kk = 2 * i + (lane >> 5); float v = 0.f;
        if (srccol0 >= 0) { v = W[(size_t)(k0 + kk) * Nsrc + srccol0 + (lane & 31)]; if (kscale) v *= kscale[k0 + kk]; }
        scr[kk * 33 + (lane & 31)] = v; }
    LDS_WAIT(); asm volatile("" ::: "memory");
    const int c = lane & 7;
#pragma unroll
    for (int j = 0; j < 4; ++j) { const int n = (lane >> 3) + 8 * j; const LAS float* s = scr + (8 * c) * 33 + n;
        v4u o; o.x = pk2(s[0 * 33], s[1 * 33]); o.y = pk2(s[2 * 33], s[3 * 33]); o.z = pk2(s[4 * 33], s[5 * 33]); o.w = pk2(s[6 * 33], s[7 * 33]);
        *(v4u*)(WT + (size_t)(n0dst + n) * K + kd0 + k0 + 8 * c) = o; }
    LDS_WAIT(); asm volatile("" ::: "memory");
}
__device__ __forceinline__ int win_srccol(int n) { return n < 6144 ? n : (n < 8192 ? n + 32 : (n < 8224 ? 6144 + (n - 8192) : -1)); }
__device__ __forceinline__ int wfi_srccol(int n) { const int t = n >> 8, r = n & 255; return r < 128 ? 128 * t + r : DFF + 128 * t + (r - 128); }

__device__ __forceinline__ void p0_weights(Frame& F) {
    LAS float* scr = (LAS float*)(F.lds + F.wave * 16384);
    const int gw = blockIdx.x * NWAVES + F.wave, NGW = F.G * NWAVES;
    constexpr int I_IN = 16 * (NPROJ / 32), I_SQ = 16 * 32, I_SSD = 32 * 32, I_FI = 16 * (2 * DFF / 32), I_FO = (DFF / 64) * 32;
    constexpr int NITEMS = I_IN + 3 * I_SQ + I_SSD + I_FI + I_FO;
    for (int it = gw; it < NITEMS; it += NGW) {
        int r = it;
        if (r < I_IN) { const int nblk = NPROJ / 32, kb = r / nblk, nb = r % nblk; cvt_item(F.in[I_WIN], 1024, 8224, WSP(bf16, WS_WIN), 32 * nb, win_srccol(32 * nb), 64 * kb, nullptr, scr, F.lane); continue; } r -= I_IN;
        if (r < I_SQ) { const int kb = r / 32, nb = r % 32; cvt_item(F.in[I_WGLU], 1024, 1024, WSP(bf16, WS_WGLU), 32 * nb, 32 * nb, 64 * kb, nullptr, scr, F.lane); continue; } r -= I_SQ;
        if (r < I_SQ) { const int kb = r / 32, nb = r % 32; cvt_item(F.in[I_WBS5], 3072, 1024, WSP(bf16, WS_WBR), 32 * nb, 32 * nb, 64 * kb, nullptr, scr, F.lane, 0); continue; } r -= I_SQ;
        if (r < I_SQ) { const int kb = r / 32, nb = r % 32; cvt_item(F.in[I_WOUT], 1024, 1024, WSP(bf16, WS_WOUT), 32 * nb, 32 * nb, 64 * kb, nullptr, scr, F.lane); continue; } r -= I_SQ;
        if (r < I_SSD) { const int kb = r / 32, nb = r % 32; cvt_item(F.in[I_WBSSD], 3072, 1024, WSP(bf16, WS_WBR), 32 * nb, 32 * nb, 64 * kb, F.in[I_MNORM], scr, F.lane, 1024); continue; } r -= I_SSD;
        if (r < I_FI) { const int nblk = 2 * DFF / 32, kb = r / nblk, nb = r % nblk; cvt_item(F.in[I_WFI], 1024, 2 * DFF, WSP(bf16, WS_WFI), 32 * nb, wfi_srccol(32 * nb), 64 * kb, nullptr, scr, F.lane); continue; } r -= I_FI;
        { const int kb = r / 32, nb = r % 32; cvt_item(F.in[I_WFO], DFF, 1024, WSP(bf16, WS_WFO), 32 * nb, 32 * nb, 64 * kb, nullptr, scr, F.lane); }
    }
}
__device__ __forceinline__ void p0_mod(Frame& F) {
    LAS float* sc = (LAS float*)F.lds;
    const float* cp = F.in[I_CP]; const float* cs = F.in[I_CS]; const float* W = F.in[I_WADA]; const float* bA = F.in[I_BADA]; float* MOD = WSP(float, WS_MOD);
    const int mt = (int)blockIdx.x % 5, ci = (int)blockIdx.x / 5, cnt = (F.G - mt + 4) / 5;
    const int lane = F.lane, r32 = lane & 31, hh = lane >> 5;
    for (int e = F.tid; e < 32 * 256; e += 512) { const int rr = e >> 8, k4 = (e & 255) * 4, r = 32 * mt + rr; f32x4 v = (f32x4){0.f, 0.f, 0.f, 0.f};
        if (r < NMOD) { v = (r < NBATCH) ? *(const f32x4*)(cp + r * 1024 + k4) : *(const f32x4*)(cs + (r - NBATCH) * 1024 + k4);
#pragma unroll
            for (int j = 0; j < 4; ++j) v[j] = v[j] / (1.0f + __expf(-v[j])); }
        *(LAS f32x4*)(sc + rr * 1028 + k4) = v; }
    __syncthreads();
    for (int nt = ci + cnt * F.wave; nt < 6144 / 32; nt += cnt * NWAVES) {
        const int n = nt * 32 + r32; const float* wp = W + (size_t)(hh * 512) * 6144 + n; const LAS float* ap = sc + r32 * 1028 + hh * 512;
        f32x16 acc;
#pragma unroll
        for (int r = 0; r < 16; ++r) acc[r] = 0.f;
#pragma unroll 2
        for (int s0 = 0; s0 < 512; s0 += 8) {
            float bw[8];
#pragma unroll
            for (int j = 0; j < 8; ++j) bw[j] = wp[(size_t)(s0 + j) * 6144];
            const f32x4 a0 = *(const LAS f32x4*)(ap + s0), a1 = *(const LAS f32x4*)(ap + s0 + 4);
#pragma unroll
            for (int j = 0; j < 4; ++j) acc = __builtin_amdgcn_mfma_f32_32x32x2f32(a0[j], bw[j], acc, 0, 0, 0);
#pragma unroll
            for (int j = 0; j < 4; ++j) acc = __builtin_amdgcn_mfma_f32_32x32x2f32(a1[j], bw[4 + j], acc, 0, 0, 0);
        }
        const float bb = bA[n];
#pragma unroll
        for (int r = 0; r < 16; ++r) { const int row = 32 * mt + rowoff(r, hh); if (row < NMOD) MOD[(size_t)row * 6144 + n] = acc[r] + bb; }
    }
    __syncthreads();
}
__device__ __forceinline__ void p0_s5consts(Frame& F) {
    const int gt = blockIdx.x * 512 + F.tid;
    if (gt < G5 * N5) {
        const int g = gt >> 6;
        const float lr = F.in[I_LRE][gt], li = F.in[I_LIM][gt], dt = expf(F.in[I_LDT][g]);
        const float th = li * dt, cs = cosf(th), sn = sinf(th), em1 = expm1f(lr * dt), mag = em1 + 1.0f, sh = sinf(0.5f * th);
        const float are = mag * cs, aim = mag * sn;
        const float nr = em1 * cs - 2.0f * sh * sh, ni = aim, den = lr * lr + li * li;
        const float fre = (nr * lr + ni * li) / den, fim = (ni * lr - nr * li) / den;
        float* AB = WSP(float, WS_ABAR); float* BB = WSP(float, WS_BBAR);
        AB[gt] = are; AB[G5 * N5 + gt] = aim;
        for (int h = 0; h < H5; ++h) { const float br = F.in[I_BRE][gt * 16 + h], bi = F.in[I_BIM][gt * 16 + h];
            BB[gt * 16 + h] = fre * br - fim * bi; BB[G5 * N5 * 16 + gt * 16 + h] = fre * bi + fim * br; }
    }
}
__device__ __forceinline__ const float* xrow(Frame& F, int m) { return m < MP ? F.in[I_XP] + (size_t)m * DM : F.in[I_XS] + (size_t)(m - MP) * DM; }
__device__ __forceinline__ int modrow(int m) { return m < MP ? (m >> 11) : NBATCH + (m - MP); }
__device__ __forceinline__ void p1_norm(Frame& F) {
    const int gw = blockIdx.x * NWAVES + F.wave, NGW = F.G * NWAVES;
    const float* gpm = F.in[I_NPM]; const float* MOD = WSP(float, WS_MOD); bf16* H = WSP(bf16, WS_H);
    for (int m = gw; m < MPAD; m += NGW) {
        unsigned long long* o8 = (unsigned long long*)(H + (size_t)m * DM) + F.lane;
        if (m >= MT) {
#pragma unroll
            for (int j = 0; j < 4; ++j) o8[64 * j] = 0ull;
            continue; }
        const f32x4* xr = (const f32x4*)xrow(F, m) + F.lane; const float* mr = MOD + (size_t)modrow(m) * 6144;
        f32x4 v[4]; float s2 = 0.f;
#pragma unroll
        for (int j = 0; j < 4; ++j) { v[j] = xr[64 * j]; s2 += (v[j].x * v[j].x + v[j].y * v[j].y) + (v[j].z * v[j].z + v[j].w * v[j].w); }
        const float rstd = 1.0f / sqrtf(wave_sum(s2) * (1.f / DM) + EPS);
#pragma unroll
        for (int j = 0; j < 4; ++j) { const int c = 4 * F.lane + 256 * j; const f32x4 g = *(const f32x4*)(gpm + c), sh = *(const f32x4*)(mr + c), sc = *(const f32x4*)(mr + 1024 + c);
            const f32x4 h = (v[j] * rstd) * g * (sc + 1.0f) + sh;
            o8[64 * j] = (unsigned long long)pk2(h.x, h.y) | ((unsigned long long)pk2(h.z, h.w) << 32); }
    }
}
__device__ __forceinline__ void unpack8(const v4u w, float (&f)[8]) { f[0] = bflo(w.x); f[1] = bfhi(w.x); f[2] = bflo(w.y); f[3] = bfhi(w.y); f[4] = bflo(w.z); f[5] = bfhi(w.z); f[6] = bflo(w.w); f[7] = bfhi(w.w); }
__device__ __forceinline__ void p_conv(Frame& F) {
    const bf16* XBC = WSP(bf16, WS_XBC); bf16* ACT = WSP(bf16, WS_ACT); const float* cw = F.in[I_CW]; const float* cb = F.in[I_CB]; const float* sconv = F.in[I_CONV];
    const int total = (MP / 16) * (CDIM / 8);
    for (int it = (int)blockIdx.x * 512 + F.tid; it < total; it += F.G * 512) {
        const int rb = it / (CDIM / 8), c0 = (it % (CDIM / 8)) * 8, m0 = rb * 16, t0 = m0 & (SEQ - 1);
        float wk[4][8], bias[8];
#pragma unroll
        for (int k = 0; k < 4; ++k) { const f32x4 a = *(const f32x4*)(cw + k * CDIM + c0), b2 = *(const f32x4*)(cw + k * CDIM + c0 + 4); wk[k][0] = a[0]; wk[k][1] = a[1]; wk[k][2] = a[2]; wk[k][3] = a[3]; wk[k][4] = b2[0]; wk[k][5] = b2[1]; wk[k][6] = b2[2]; wk[k][7] = b2[3]; }
        { const f32x4 a = *(const f32x4*)(cb + c0), b2 = *(const f32x4*)(cb + c0 + 4); bias[0] = a[0]; bias[1] = a[1]; bias[2] = a[2]; bias[3] = a[3]; bias[4] = b2[0]; bias[5] = b2[1]; bias[6] = b2[2]; bias[7] = b2[3]; }
        float h0[8], h1[8], h2[8];
        if (t0 == 0) {
#pragma unroll
            for (int e = 0; e < 8; ++e) { h0[e] = 0.f; h1[e] = 0.f; h2[e] = 0.f; }
        } else { unpack8(*(const v4u*)(XBC + (size_t)(m0 - 3) * CDIM + c0), h0); unpack8(*(const v4u*)(XBC + (size_t)(m0 - 2) * CDIM + c0), h1); unpack8(*(const v4u*)(XBC + (size_t)(m0 - 1) * CDIM + c0), h2); }
        v4u raw[16];
#pragma unroll
        for (int r = 0; r < 16; ++r) raw[r] = *(const v4u*)(XBC + (size_t)(m0 + r) * CDIM + c0);
#pragma unroll
        for (int r = 0; r < 16; ++r) { float x[8], a[8]; unpack8(raw[r], x);
#pragma unroll
            for (int e = 0; e < 8; ++e) { const float v = bias[e] + wk[0][e] * h0[e] + wk[1][e] * h1[e] + wk[2][e] * h2[e] + wk[3][e] * x[e]; a[e] = siluf_(v); h0[e] = h1[e]; h1[e] = h2[e]; h2[e] = x[e]; }
            v4u o; o.x = pk2(a[0], a[1]); o.y = pk2(a[2], a[3]); o.z = pk2(a[4], a[5]); o.w = pk2(a[6], a[7]);
            *(v4u*)(ACT + (size_t)(m0 + r) * CDIM + c0) = o; }
        if (t0 == SEQ - 16) { float* o = F.out + O_CONVP + ((size_t)(m0 >> 11) * 3) * CDIM + c0;
#pragma unroll
            for (int e = 0; e < 8; ++e) { o[e] = h0[e]; o[CDIM + e] = h1[e]; o[2 * CDIM + e] = h2[e]; } }
    }
    for (int it = (int)blockIdx.x * 512 + F.tid; it < MS * (CDIM / 8); it += F.G * 512) {
        const int s_ = it / (CDIM / 8), c0 = (it % (CDIM / 8)) * 8, m = MP + s_;
        float tap[4][8];
#pragma unroll
        for (int k = 0; k < 3; ++k) { const float* sp = sconv + ((size_t)s_ * 3 + k) * CDIM + c0;
#pragma unroll
            for (int e = 0; e < 8; ++e) tap[k][e] = sp[e]; }
        unpack8(*(const v4u*)(XBC + (size_t)m * CDIM + c0), tap[3]);
#pragma unroll
        for (int k = 0; k < 3; ++k) { float* o = F.out + O_CONVS + ((size_t)s_ * 3 + k) * CDIM + c0;
#pragma unroll
            for (int e = 0; e < 8; ++e) o[e] = tap[k + 1][e]; }
        float a[8];
#pragma unroll
        for (int e = 0; e < 8; ++e) { float v = cb[c0 + e];
#pragma unroll
            for (int k = 0; k < 4; ++k) v += cw[k * CDIM + c0 + e] * tap[k][e];
            a[e] = siluf_(v); }
        v4u o; o.x = pk2(a[0], a[1]); o.y = pk2(a[2], a[3]); o.z = pk2(a[4], a[5]); o.w = pk2(a[6], a[7]);
        *(v4u*)(ACT + (size_t)m * CDIM + c0) = o;
    }
}
__device__ __forceinline__ void s5_prompt_unit(Frame& F, int b, int g, LAS float* wl) {
    LAS float* XR = wl; LAS float* XI = wl + 64 * 65; LAS float* CR = wl + 2 * 64 * 65; LAS float* CI = CR + 16 * 64;
    const int n = F.lane; const float* AB = WSP(float, WS_ABAR); const float* BB = WSP(float, WS_BBAR);
    const float abr = AB[g * 64 + n], abi = AB[G5 * N5 + g * 64 + n];
    float bre[16], bim[16];
#pragma unroll
    for (int h = 0; h < 16; ++h) { bre[h] = BB[(g * 64 + n) * 16 + h]; bim[h] = BB[G5 * N5 * 16 + (g * 64 + n) * 16 + h]; }
    for (int h = 0; h < 16; ++h) { CR[h * 64 + n] = F.in[I_CRE][(g * 16 + h) * 64 + n]; CI[h * 64 + n] = F.in[I_CIM][(g * 16 + h) * 64 + n]; }
    float dsk[16];
#pragma unroll
    for (int h = 0; h < 16; ++h) dsk[h] = F.in[I_S5D][g * 16 + h];
    const bf16* U = WSP(bf16, WS_U); bf16* YA = WSP(bf16, WS_YA);
    float xr = 0.f, xi = 0.f;
    for (int tb = 0; tb < SEQ / 64; ++tb) {
        const size_t rowb = (size_t)b * SEQ + tb * 64;
        for (int tt = 0; tt < 64; ++tt) {
            const v4u w0 = *(const v4u*)(U + (rowb + tt) * DM + g * 16), w1 = *(const v4u*)(U + (rowb + tt) * DM + g * 16 + 8);
            const float uv[16] = {bflo(w0.x), bfhi(w0.x), bflo(w0.y), bfhi(w0.y), bflo(w0.z), bfhi(w0.z), bflo(w0.w), bfhi(w0.w), bflo(w1.x), bfhi(w1.x), bflo(w1.y), bfhi(w1.y), bflo(w1.z), bfhi(w1.z), bflo(w1.w), bfhi(w1.w)};
            float bur = 0.f, bui = 0.f;
#pragma unroll
            for (int h = 0; h < 16; ++h) { bur += bre[h] * uv[h]; bui += bim[h] * uv[h]; }
            const float nxr = abr * xr - abi * xi + bur, nxi = abr * xi + abi * xr + bui; xr = nxr; xi = nxi;
            XR[tt * 65 + n] = xr; XI[tt * 65 + n] = xi;
        }
        LDS_WAIT(); asm volatile("" ::: "memory");
        float acc[16];
#pragma unroll
        for (int h = 0; h < 16; ++h) acc[h] = 0.f;
        for (int n2 = 0; n2 < 64; ++n2) { const float a = XR[F.lane * 65 + n2], c = XI[F.lane * 65 + n2];
#pragma unroll
            for (int h = 0; h < 16; ++h) acc[h] += CR[h * 64 + n2] * a - CI[h * 64 + n2] * c; }
        {
            const size_t row = rowb + F.lane;
            const v4u w0 = *(const v4u*)(U + row * DM + g * 16), w1 = *(const v4u*)(U + row * DM + g * 16 + 8);
            const float uv[16] = {bflo(w0.x), bfhi(w0.x), bflo(w0.y), bfhi(w0.y), bflo(w0.z), bfhi(w0.z), bflo(w0.w), bfhi(w0.w), bflo(w1.x), bfhi(w1.x), bflo(w1.y), bfhi(w1.y), bflo(w1.z), bfhi(w1.z), bflo(w1.w), bfhi(w1.w)};
            float o[16];
#pragma unroll
            for (int h = 0; h < 16; ++h) o[h] = gelu_tanh(acc[h] + dsk[h] * uv[h]);
            v4u p0, p1; p0.x = pk2(o[0], o[1]); p0.y = pk2(o[2], o[3]); p0.z = pk2(o[4], o[5]); p0.w = pk2(o[6], o[7]); p1.x = pk2(o[8], o[9]); p1.y = pk2(o[10], o[11]); p1.z = pk2(o[12], o[13]); p1.w = pk2(o[14], o[15]);
            *(v4u*)(YA + row * DM + g * 16) = p0; *(v4u*)(YA + row * DM + g * 16 + 8) = p1;
        }
        LDS_WAIT(); asm volatile("" ::: "memory");
    }
    F.out[O_S5RP + (size_t)(b * G5 + g) * N5 + n] = xr; F.out[O_S5IP + (size_t)(b * G5 + g) * N5 + n] = xi;
}
__device__ __forceinline__ void s5_sample_unit(Frame& F, int s, int g) {
    const int n = F.lane; const float* AB = WSP(float, WS_ABAR); const float* BB = WSP(float, WS_BBAR);
    const float abr = AB[g * 64 + n], abi = AB[G5 * N5 + g * 64 + n];
    const bf16* U = WSP(bf16, WS_U); bf16* YA = WSP(bf16, WS_YA);
    const size_t row = (size_t)MP + s;
    const v4u w0 = *(const v4u*)(U + row * DM + g * 16), w1 = *(const v4u*)(U + row * DM + g * 16 + 8);
    const float uv[16] = {bflo(w0.x), bfhi(w0.x), bflo(w0.y), bfhi(w0.y), bflo(w0.z), bfhi(w0.z), bflo(w0.w), bfhi(w0.w), bflo(w1.x), bfhi(w1.x), bflo(w1.y), bfhi(w1.y), bflo(w1.z), bfhi(w1.z), bflo(w1.w), bfhi(w1.w)};
    float bur = 0.f, bui = 0.f;
#pragma unroll
    for (int h = 0; h < 16; ++h) { bur += BB[(g * 64 + n) * 16 + h] * uv[h]; bui += BB[G5 * N5 * 16 + (g * 64 + n) * 16 + h] * uv[h]; }
    const size_t si = ((size_t)s * G5 + g) * N5 + n;
    const float h0r = F.in[I_S5RE][si], h0i = F.in[I_S5IM][si];
    const float xr = abr * h0r - abi * h0i + bur, xi = abr * h0i + abi * h0r + bui;
    F.out[O_S5RS + si] = xr; F.out[O_S5IS + si] = xi;
    float o[16];
#pragma unroll
    for (int h = 0; h < 16; ++h) { const float y = wave_sum(F.in[I_CRE][(g * 16 + h) * 64 + n] * xr - F.in[I_CIM][(g * 16 + h) * 64 + n] * xi); o[h] = gelu_tanh(y + F.in[I_S5D][g * 16 + h] * uv[h]); }
    if (n == 0) { v4u p0, p1; p0.x = pk2(o[0], o[1]); p0.y = pk2(o[2], o[3]); p0.z = pk2(o[4], o[5]); p0.w = pk2(o[6], o[7]); p1.x = pk2(o[8], o[9]); p1.y = pk2(o[10], o[11]); p1.z = pk2(o[12], o[13]); p1.w = pk2(o[14], o[15]);
        *(v4u*)(YA + row * DM + g * 16) = p0; *(v4u*)(YA + row * DM + g * 16 + 8) = p1; }
}
typedef short s16x4 __attribute__((ext_vector_type(4)));
__device__ __forceinline__ unsigned offB(unsigned row, unsigned ch) { return 256u * row + 16u * (ch ^ (((row & 3u) << 2) | ((row >> 2) & 3u))); }
__device__ __forceinline__ unsigned offX(unsigned row, unsigned ch) { return 128u * row + 16u * (ch ^ (((row >> 1) & 1u) << 2)); }
__device__ __forceinline__ unsigned offG(unsigned row, unsigned ch) { return 128u * row + 16u * (ch ^ ((row >> 1) & 7u)); }
__device__ __forceinline__ bf16x8 tr_frag(LAS unsigned char* base, unsigned a0, unsigned a1) {
    const s16x4 lo = __builtin_bit_cast(s16x4, __builtin_amdgcn_ds_read_tr16_b64_v4i16((LAS s16x4*)(base + a0)));
    const s16x4 hi = __builtin_bit_cast(s16x4, __builtin_amdgcn_ds_read_tr16_b64_v4i16((LAS s16x4*)(base + a1)));
    return (bf16x8){lo[0], lo[1], lo[2], lo[3], hi[0], hi[1], hi[2], hi[3]};
}
constexpr int SL_BM = 0, SL_CM = 16384, SL_HS = 32768, SL_XS = 49152  , SL_ZT = 65536  , SL_XT = 81920  , SL_XW = 98304, SL_GL = 106496, SL_YS = 114688  , SL_TB = 131072;
#define WG_BAR() do { asm volatile("s_waitcnt lgkmcnt(0)" ::: "memory"); __builtin_amdgcn_s_barrier(); asm volatile("" ::: "memory"); } while (0)
__device__ __forceinline__ void ssd_prompt_mfma(Frame& F, int b, int head) {
    LAS unsigned char* L = F.lds;
    const bf16* ACT = WSP(bf16, WS_ACT); const bf16* Z = WSP(bf16, WS_Z); const float* DT = WSP(float, WS_DT); bf16* GY = WSP(bf16, WS_GY); float* SSQ = WSP(float, WS_SSQ);
    const int tid = F.tid, lane = F.lane, w = F.wave, grp = head >> 3, r32 = lane & 31, hh = lane >> 5;
    const float A = -expf(F.in[I_ALOG][head]), Dh = F.in[I_MD][head];
    const size_t rowb = (size_t)b * SEQ;
    LAS float* TB_CS = (LAS float*)(L + SL_TB); LAS float* TB_ECS = TB_CS + 64;
    for (int e = tid; e < 16384 / 16; e += 512) *(LAS v4u*)(L + SL_HS + e * 16) = (v4u){0u, 0u, 0u, 0u};
    f32x16 hacc;
#pragma unroll
    for (int r = 0; r < 16; ++r) hacc[r] = 0.f;
    const int lB0 = tid >> 4, chB = tid & 15, lB1 = lB0 + 32, lX = tid >> 3, chX = tid & 7;
    const unsigned tq = (lane & 15) >> 2, tp = lane & 3, tblk = (lane >> 4) & 1;
    v4u pfB0, pfB1, pfC0, pfC1, pfX, pfZ; float pfdt; float decay = 1.f;
#define SSD_PREFETCH(cc) do { const size_t r0_ = rowb + (size_t)(cc) * 64; \
        pfB0 = *(const v4u*)(ACT + (r0_ + lB0) * CDIM + 2048 + grp * 128 + chB * 8); pfB1 = *(const v4u*)(ACT + (r0_ + lB1) * CDIM + 2048 + grp * 128 + chB * 8); \
        pfC0 = *(const v4u*)(ACT + (r0_ + lB0) * CDIM + 2560 + grp * 128 + chB * 8); pfC1 = *(const v4u*)(ACT + (r0_ + lB1) * CDIM + 2560 + grp * 128 + chB * 8); \
        pfX = *(const v4u*)(ACT + (r0_ + lX) * CDIM + head * 64 + chX * 8); pfZ = *(const v4u*)(Z + (r0_ + lX) * MIN + head * 64 + chX * 8); \
        pfdt = DT[(r0_ + lane) * 32 + head]; } while (0)
#define SSD_STAGE(cc) do { const int bf_ = (cc) & 1; \
        *(LAS v4u*)(L + SL_BM + offB(lB0, chB)) = pfB0; *(LAS v4u*)(L + SL_BM + offB(lB1, chB)) = pfB1; \
        *(LAS v4u*)(L + SL_CM + offB(lB0, chB)) = pfC0; *(LAS v4u*)(L + SL_CM + offB(lB1, chB)) = pfC1; \
        *(LAS v4u*)(L + SL_XS + bf_ * 8192 + offX(lX, chX)) = pfX; *(LAS v4u*)(L + SL_ZT + bf_ * 8192 + lX * 128 + chX * 16) = pfZ; \
        float cs_ = pfdt * A; \
        _Pragma("unroll") for (int o_ = 1; o_ < 64; o_ <<= 1) { const float t_ = __shfl_up(cs_, o_); if (lane >= o_) cs_ += t_; } \
        const float csl_ = __shfl(cs_, 63); \
        if (w == 0) { TB_CS[lane] = cs_; TB_ECS[lane] = __expf(cs_); } \
        const float dtl_ = __shfl(pfdt, lX), wl_ = __expf(csl_ - __shfl(cs_, lX)); \
        float xv_[8]; unpack8(pfX, xv_); float xd_[8], xq_[8]; \
        _Pragma("unroll") for (int e_ = 0; e_ < 8; ++e_) { xd_[e_] = xv_[e_] * dtl_; xq_[e_] = xd_[e_] * wl_; } \
        v4u a_, q_; a_.x = pk2(xd_[0], xd_[1]); a_.y = pk2(xd_[2], xd_[3]); a_.z = pk2(xd_[4], xd_[5]); a_.w = pk2(xd_[6], xd_[7]); q_.x = pk2(xq_[0], xq_[1]); q_.y = pk2(xq_[2], xq_[3]); q_.z = pk2(xq_[4], xq_[5]); q_.w = pk2(xq_[6], xq_[7]); \
        *(LAS v4u*)(L + SL_XT + bf_ * 8192 + offX(lX, chX)) = a_; *(LAS v4u*)(L + SL_XW + offX(lX, chX)) = q_; \
        decay = __expf(csl_); } while (0)
    SSD_PREFETCH(0);
    SSD_STAGE(0);
    SSD_PREFETCH(1);
    WG_BAR();
    constexpr int NCH = SEQ / 64;
    for (int c = 0; c < NCH; ++c) {
        const int buf = c & 1;
        f32x16 yacc;
#pragma unroll
        for (int r = 0; r < 16; ++r) yacc[r] = 0.f;
        if (w < 4) {
            const int lt = w >> 1, pt = w & 1; bf16x8 fa[8], fb[8];
#pragma unroll
            for (int ks = 0; ks < 8; ++ks) { fa[ks] = *(const LAS bf16x8*)(L + SL_CM + offB(32 * lt + r32, 2 * ks + hh)); fb[ks] = *(const LAS bf16x8*)(L + SL_HS + offB(32 * pt + r32, 2 * ks + hh)); }
            f32x16 y2;
#pragma unroll
            for (int r = 0; r < 16; ++r) y2[r] = 0.f;
#pragma unroll
            for (int ks = 0; ks < 8; ks += 2) { yacc = __builtin_amdgcn_mfma_f32_32x32x16_bf16(fa[ks], fb[ks], yacc, 0, 0, 0); y2 = __builtin_amdgcn_mfma_f32_32x32x16_bf16(fa[ks + 1], fb[ks + 1], y2, 0, 0, 0); }
#pragma unroll
            for (int r = 0; r < 16; ++r) yacc[r] = (yacc[r] + y2[r]) * TB_ECS[32 * lt + rowoff(r, hh)];
        } else if (w < 7) {
            const int lt = (w == 4) ? 0 : 1, st = (w == 6) ? 1 : 0; bf16x8 fa[8], fb[8];
#pragma unroll
            for (int ks = 0; ks < 8; ++ks) { fa[ks] = *(const LAS bf16x8*)(L + SL_CM + offB(32 * lt + r32, 2 * ks + hh)); fb[ks] = *(const LAS bf16x8*)(L + SL_BM + offB(32 * st + r32, 2 * ks + hh)); }
            f32x16 g, g2;
#pragma unroll
            for (int r = 0; r < 16; ++r) { g[r] = 0.f; g2[r] = 0.f; }
#pragma unroll
            for (int ks = 0; ks < 8; ks += 2) { g = __builtin_amdgcn_mfma_f32_32x32x16_bf16(fa[ks], fb[ks], g, 0, 0, 0); g2 = __builtin_amdgcn_mfma_f32_32x32x16_bf16(fa[ks + 1], fb[ks + 1], g2, 0, 0, 0); }
            const int s = 32 * st + r32; const float css = TB_CS[s];
#pragma unroll
            for (int r = 0; r < 16; ++r) { const int l = 32 * lt + rowoff(r, hh); const float ex = __expf(fminf(TB_CS[l] - css, 0.f)); const float v = (s <= l) ? (g[r] + g2[r]) * ex : 0.f;
                *(LAS bf16*)(L + SL_GL + offG(l, s >> 3) + (s & 7) * 2) = (bf16)f2bf(v); }
        }
        {
            const int pt = w & 1, nt = w >> 1; bf16x8 fa[4], fb[4];
#pragma unroll
            for (int ks = 0; ks < 4; ++ks) { const unsigned k0 = 16 * ks + 8 * hh + tq;
                fa[ks] = tr_frag(L + SL_XW, offX(k0, 4 * pt + 2 * tblk + (tp >> 1)) + 8 * (tp & 1), offX(k0 + 4, 4 * pt + 2 * tblk + (tp >> 1)) + 8 * (tp & 1));
                fb[ks] = tr_frag(L + SL_BM, offB(k0, 4 * nt + 2 * tblk + (tp >> 1)) + 8 * (tp & 1), offB(k0 + 4, 4 * nt + 2 * tblk + (tp >> 1)) + 8 * (tp & 1)); }
            f32x16 h2;
#pragma unroll
            for (int r = 0; r < 16; ++r) { hacc[r] *= decay; h2[r] = 0.f; }
            hacc = __builtin_amdgcn_mfma_f32_32x32x16_bf16(fa[0], fb[0], hacc, 0, 0, 0); h2 = __builtin_amdgcn_mfma_f32_32x32x16_bf16(fa[1], fb[1], h2, 0, 0, 0);
            hacc = __builtin_amdgcn_mfma_f32_32x32x16_bf16(fa[2], fb[2], hacc, 0, 0, 0); h2 = __builtin_amdgcn_mfma_f32_32x32x16_bf16(fa[3], fb[3], h2, 0, 0, 0);
#pragma unroll
            for (int r = 0; r < 16; ++r) hacc[r] += h2[r];
        }
#define SSD_EPI(cc) do { const int pb_ = (cc) & 1; const size_t row_ = rowb + (size_t)(cc) * 64 + lX; \
            const f32x4 y0_ = *(const LAS f32x4*)(L + SL_YS + lX * 256 + chX * 32), y1_ = *(const LAS f32x4*)(L + SL_YS + lX * 256 + chX * 32 + 16); \
            float xv_[8], zv_[8]; unpack8(*(const LAS v4u*)(L + SL_XS + pb_ * 8192 + offX(lX, chX)), xv_); unpack8(*(const LAS v4u*)(L + SL_ZT + pb_ * 8192 + lX * 128 + chX * 16), zv_); \
            const float yv_[8] = {y0_[0], y0_[1], y0_[2], y0_[3], y1_[0], y1_[1], y1_[2], y1_[3]}; float o_[8]; \
            _Pragma("unroll") for (int e_ = 0; e_ < 8; ++e_) o_[e_] = (yv_[e_] + Dh * xv_[e_]) * siluf_(zv_[e_]); \
            v4u ow_; ow_.x = pk2(o_[0], o_[1]); ow_.y = pk2(o_[2], o_[3]); ow_.z = pk2(o_[4], o_[5]); ow_.w = pk2(o_[6], o_[7]); \
            *(v4u*)(GY + row_ * 3072 + 1024 + head * 64 + chX * 8) = ow_; \
            float q2_ = (o_[0] * o_[0] + o_[1] * o_[1]) + (o_[2] * o_[2] + o_[3] * o_[3]) + (o_[4] * o_[4] + o_[5] * o_[5]) + (o_[6] * o_[6] + o_[7] * o_[7]); \
            q2_ += __shfl_xor(q2_, 1); q2_ += __shfl_xor(q2_, 2); q2_ += __shfl_xor(q2_, 4); \
            if (chX == 0) SSQ[row_ * 32 + head] = q2_; } while (0)
        if (c > 0) SSD_EPI(c - 1);
        WG_BAR();
        if (w < 4) {
            const int lt = w >> 1, pt = w & 1;
            for (int ks = 0; ks < 2 * (lt + 1); ++ks) { const unsigned k0 = 16 * ks + 8 * hh + tq;
                const bf16x8 a = *(const LAS bf16x8*)(L + SL_GL + offG(32 * lt + r32, 2 * ks + hh));
                const bf16x8 bb = tr_frag(L + SL_XT + buf * 8192, offX(k0, 4 * pt + 2 * tblk + (tp >> 1)) + 8 * (tp & 1), offX(k0 + 4, 4 * pt + 2 * tblk + (tp >> 1)) + 8 * (tp & 1));
                yacc = __builtin_amdgcn_mfma_f32_32x32x16_bf16(a, bb, yacc, 0, 0, 0); }
#pragma unroll
            for (int r = 0; r < 16; ++r) *(LAS float*)(L + SL_YS + (32 * lt + rowoff(r, hh)) * 256 + (32 * pt + r32) * 4) = yacc[r];
        }
        {   const int pt = w & 1, nt = w >> 1; const int n = 32 * nt + r32;
#pragma unroll
            for (int r = 0; r < 16; ++r) { const int p = 32 * pt + rowoff(r, hh); *(LAS bf16*)(L + SL_HS + offB(p, n >> 3) + (n & 7) * 2) = (bf16)f2bf(hacc[r]); }
        }
        if (c + 1 < NCH) { SSD_STAGE(c + 1); if (c + 2 < NCH) SSD_PREFETCH(c + 2); }
        WG_BAR();
    }
    SSD_EPI(NCH - 1);
    {   float* ho = F.out + O_SSMP + (size_t)(b * NH + head) * HD * NST; const int pt = w & 1, nt = w >> 1;
#pragma unroll
        for (int r = 0; r < 16; ++r) ho[(size_t)(32 * pt + rowoff(r, hh)) * NST + 32 * nt + r32] = hacc[r];
    }
#undef SSD_PREFETCH
#undef SSD_STAGE
#undef SSD_EPI
    __syncthreads();
}

__device__ __forceinline__ void p0_s5tables(Frame& F) {
    LAS float* PR = (LAS float*)F.lds; LAS float* PI = PR + 64 * 33; LAS float* BR = PI + 64 * 33; LAS float* BI = BR + 1024; LAS float* CR = BI + 1024; LAS float* CI = CR + 1024;
    bf16* KT = WSP(bf16, WS_KT); bf16* SMF = WSP(bf16, WS_SMF); bf16* OMF = WSP(bf16, WS_OMF); float* A32 = WSP(float, WS_A32);
    const int tid = F.tid;
    for (int job = blockIdx.x; job < G5 * 4; job += F.G) {
        const int g = job >> 2, q = job & 3;
        __syncthreads();
        const float dt = expf(F.in[I_LDT][g]);
        for (int e = tid; e < 64 * 33; e += 512) { const int n = e / 33, d = e % 33; const float lr = F.in[I_LRE][g * 64 + n], li = F.in[I_LIM][g * 64 + n];
            const float mg = expf(lr * dt * (float)d), th = li * dt * (float)d; PR[e] = mg * cosf(th); PI[e] = mg * sinf(th); }
        for (int e = tid; e < 1024; e += 512) { const int n = e >> 4; const float lr = F.in[I_LRE][g * 64 + n], li = F.in[I_LIM][g * 64 + n];
            const float th = li * dt, cs = cosf(th), sn = sinf(th), em1 = expm1f(lr * dt), mag = em1 + 1.0f, sh = sinf(0.5f * th);
            const float nr = em1 * cs - 2.0f * sh * sh, ni = mag * sn, den = lr * lr + li * li;
            const float fre = (nr * lr + ni * li) / den, fim = (ni * lr - nr * li) / den;
            const float br = F.in[I_BRE][(g * 64 + n) * 16 + (e & 15)], bi = F.in[I_BIM][(g * 64 + n) * 16 + (e & 15)];
            BR[e] = fre * br - fim * bi; BI[e] = fre * bi + fim * br; }
        for (int e = tid; e < 1024; e += 512) { CR[e] = F.in[I_CRE][g * 1024 + e]; CI[e] = F.in[I_CIM][g * 1024 + e]; }
        __syncthreads();
        for (int o = tid; o < 8 * 256; o += 512) { const int d = 8 * q + (o >> 8), h = (o >> 4) & 15, hp = o & 15; float acc = 0.f;
            for (int n = 0; n < 64; ++n) { const float cr = CR[h * 64 + n], ci = CI[h * 64 + n], pr = PR[n * 33 + d], pi = PI[n * 33 + d];
                acc += (cr * pr - ci * pi) * BR[n * 16 + hp] - (cr * pi + ci * pr) * BI[n * 16 + hp]; }
            KT[(size_t)(g * 33 + d + 1) * 256 + h * 16 + hp] = (bf16)f2bf(acc); }
        if (q == 0) { if (tid < 256) KT[(size_t)(g * 33) * 256 + tid] = 0; if (tid < 64) { A32[g * 64 + tid] = PR[tid * 33 + 32]; A32[G5 * N5 + g * 64 + tid] = PI[tid * 33 + 32]; } }
        for (int idx = tid; idx < 32 * 512; idx += 512) { const int jj = idx & 7, ln = (idx >> 3) & 63, ks = idx >> 9;
            const int rho = 32 * q + (ln & 31), ri = rho >> 6, n = rho & 63, hp = 8 * (ln >> 5) + jj, d = 31 - ks;
            const float pr = PR[n * 33 + d], pi = PI[n * 33 + d], br = BR[n * 16 + hp], bi = BI[n * 16 + hp];
            SMF[((size_t)(g * 4 + q) * 32 + ks) * 512 + ln * 8 + jj] = (bf16)f2bf(ri ? (pr * bi + pi * br) : (pr * br - pi * bi)); }
        for (int idx = tid; idx < 4 * 8 * 512; idx += 512) { const int jj = idx & 7, ln = (idx >> 3) & 63, ks = (idx >> 9) & 7, m = 4 * q + (idx >> 12);
            const int r32 = ln & 31, il = r32 >> 4, h = r32 & 15, i = 2 * m + il, kap = 16 * ks + 8 * (ln >> 5) + jj, ri = kap >> 6, n = kap & 63;
            const float pr = PR[n * 33 + i + 1], pi = PI[n * 33 + i + 1], cr = CR[h * 64 + n], ci = CI[h * 64 + n];
            OMF[((size_t)(g * 16 + m) * 8 + ks) * 512 + ln * 8 + jj] = (bf16)f2bf(ri ? (-cr * pi - ci * pr) : (cr * pr - ci * pi)); }
    }
    __syncthreads();
}
constexpr int S5_KT = 0, S5_UL = 17408, S5_SB = 51200, S5_XIN = 86016;
__device__ __forceinline__ void s5_prompt_mfma(Frame& F, int g, int bp) {
    LAS unsigned char* L = F.lds;
    const bf16* U = WSP(bf16, WS_U); bf16* YA = WSP(bf16, WS_YA); const bf16* SMF = WSP(bf16, WS_SMF); const bf16* OMF = WSP(bf16, WS_OMF); const float* A32 = WSP(float, WS_A32);
    const int tid = F.tid, lane = F.lane, w = F.wave, r32 = lane & 31, hh = lane >> 5;
    {   const v4u* src = (const v4u*)(WSP(bf16, WS_KT) + (size_t)g * 33 * 256);
        for (int e = tid; e < 33 * 512 / 16; e += 512) *(LAS v4u*)(L + S5_KT + e * 16) = src[e]; }
    float xr = 0.f, xi = 0.f; const float a32r = A32[g * 64 + lane], a32i = A32[G5 * N5 + g * 64 + lane];
    float dv[2][4];
#pragma unroll
    for (int x = 0; x < 2; ++x)
#pragma unroll
        for (int e = 0; e < 4; ++e) dv[x][e] = F.in[I_S5D][g * 16 + 8 * x + 4 * hh + e];
    LAS float* SB = (LAS float*)(L + S5_SB);
    for (int nt = 0; nt < 4; ++nt) {
        const int batch = 2 * bp + (nt >> 1); const size_t rowbase = (size_t)batch * SEQ + (size_t)(nt & 1) * 1024;
#pragma unroll
        for (int i = 0; i < 4; ++i) { const int e = tid + 512 * i, tau = e >> 1, half = e & 1;
            *(LAS v4u*)(L + S5_UL + (tau >> 5) * 1040 + (tau & 31) * 32 + half * 16) = *(const v4u*)(U + (rowbase + tau) * DM + g * 16 + 8 * half); }
        if ((nt & 1) == 0) { xr = 0.f; xi = 0.f; }
        __syncthreads();
        {   const int mt = w & 3, kh = w >> 2; f32x16 acc;
#pragma unroll
            for (int r = 0; r < 16; ++r) acc[r] = 0.f;
#pragma unroll 4
            for (int jj = 0; jj < 16; ++jj) { const int j = 16 * kh + jj;
                const bf16x8 a = *(const bf16x8*)(SMF + (((size_t)(g * 4 + mt) * 32 + j) * 64 + lane) * 8);
                const bf16x8 bb = *(const LAS bf16x8*)(L + S5_UL + r32 * 1040 + j * 32 + hh * 16);
                acc = __builtin_amdgcn_mfma_f32_32x32x16_bf16(a, bb, acc, 0, 0, 0); }
#pragma unroll
            for (int r = 0; r < 16; ++r) SB[(kh * 128 + 32 * mt + rowoff(r, hh)) * 33 + r32] = acc[r];
        }
        __syncthreads();
        if (w == 0) {
            const int n = lane;
            for (int c = 0; c < 32; ++c) {
                *(LAS bf16*)(L + S5_XIN + offB(c, n >> 3) + (n & 7) * 2) = (bf16)f2bf(xr); *(LAS bf16*)(L + S5_XIN + offB(c, 8 + (n >> 3)) + (n & 7) * 2) = (bf16)f2bf(xi);
                const float sr = SB[n * 33 + c] + SB[(128 + n) * 33 + c], si = SB[(64 + n) * 33 + c] + SB[(192 + n) * 33 + c];
                const float nr = a32r * xr - a32i * xi + sr, ni = a32r * xi + a32i * xr + si; xr = nr; xi = ni; }
            if (nt & 1) { F.out[O_S5RP + (size_t)(batch * G5 + g) * N5 + n] = xr; F.out[O_S5IP + (size_t)(batch * G5 + g) * N5 + n] = xi; }
        }
        __syncthreads();
        for (int mi = 0; mi < 2; ++mi) {
            const int m = mi ? 15 - w : w; f32x16 acc;
#pragma unroll
            for (int r = 0; r < 16; ++r) acc[r] = 0.f;
            for (int j = 0; j <= 2 * m + 1; ++j) { const int lag1 = 2 * m + (r32 >> 4) - j + 1;
                const bf16x8 a = *(const LAS bf16x8*)(L + S5_KT + (lag1 * 256 + (r32 & 15) * 16 + 8 * hh) * 2);
                const bf16x8 bb = *(const LAS bf16x8*)(L + S5_UL + r32 * 1040 + j * 32 + hh * 16);
                acc = __builtin_amdgcn_mfma_f32_32x32x16_bf16(a, bb, acc, 0, 0, 0); }
#pragma unroll
            for (int ks = 0; ks < 8; ++ks) { const bf16x8 a = *(const bf16x8*)(OMF + (((size_t)(g * 16 + m) * 8 + ks) * 64 + lane) * 8);
                const bf16x8 bb = *(const LAS bf16x8*)(L + S5_XIN + offB(r32, 2 * ks + hh));
                acc = __builtin_amdgcn_mfma_f32_32x32x16_bf16(a, bb, acc, 0, 0, 0); }
#pragma unroll
            for (int q = 0; q < 4; ++q) { const int il = q >> 1, h0 = 8 * (q & 1) + 4 * hh, j = 2 * m + il;
                const v2u uw = *(const LAS v2u*)(L + S5_UL + r32 * 1040 + j * 32 + h0 * 2);
                const float uv[4] = {bflo(uw.x), bfhi(uw.x), bflo(uw.y), bfhi(uw.y)}; float o[4];
#pragma unroll
                for (int e = 0; e < 4; ++e) o[e] = gelu_tanh(acc[4 * q + e] + dv[q & 1][e] * uv[e]);
                v2u ow; ow.x = pk2(o[0], o[1]); ow.y = pk2(o[2], o[3]);
                *(v2u*)(YA + (rowbase + (size_t)r32 * 32 + j) * DM + g * 16 + h0) = ow; }
        }
        __syncthreads();
    }
}

__device__ __forceinline__ void ssd_sample_waves(Frame& F) {
    const bf16* ACT = WSP(bf16, WS_ACT); const bf16* Z = WSP(bf16, WS_Z); const float* DT = WSP(float, WS_DT); bf16* GY = WSP(bf16, WS_GY);
    const float* S0 = F.in[I_SSM]; float* SO = F.out + O_SSMS;
    const int lane = F.lane, pp = lane >> 3, q = lane & 7, p = 8 * F.wave + pp;
    int u = blockIdx.x; if (u >= MS * NH) return;
    f32x4 hn[4];
#pragma unroll
    for (int j = 0; j < 4; ++j) hn[j] = *(const f32x4*)(S0 + ((size_t)u * HD + p) * NST + 32 * j + 4 * q);
    for (; u < MS * NH; u += F.G) {
        f32x4 h[4];
#pragma unroll
        for (int j = 0; j < 4; ++j) h[j] = hn[j];
        const int un = u + F.G;
        if (un < MS * NH) {
#pragma unroll
            for (int j = 0; j < 4; ++j) hn[j] = *(const f32x4*)(S0 + ((size_t)un * HD + p) * NST + 32 * j + 4 * q); }
        const int s_ = u >> 5, head = u & 31, grp = head >> 3; const size_t row = (size_t)MP + s_;
        const float dt = DT[row * 32 + head], a = __expf(-expf(F.in[I_ALOG][head]) * dt), xs = bf2f(ACT[row * CDIM + head * 64 + p]), xdt = xs * dt;
        float yp = 0.f;
#pragma unroll
        for (int j = 0; j < 4; ++j) { const v2u bw = *(const v2u*)(ACT + row * CDIM + 2048 + grp * 128 + 32 * j + 4 * q), cw2 = *(const v2u*)(ACT + row * CDIM + 2560 + grp * 128 + 32 * j + 4 * q);
            const float Bv[4] = {bflo(bw.x), bfhi(bw.x), bflo(bw.y), bfhi(bw.y)}, Cv[4] = {bflo(cw2.x), bfhi(cw2.x), bflo(cw2.y), bfhi(cw2.y)};
#pragma unroll
            for (int e = 0; e < 4; ++e) { h[j][e] = a * h[j][e] + xdt * Bv[e]; yp += Cv[e] * h[j][e]; } }
#pragma unroll
        for (int j = 0; j < 4; ++j) *(f32x4*)(SO + ((size_t)u * HD + p) * NST + 32 * j + 4 * q) = h[j];
        yp += __shfl_xor(yp, 1); yp += __shfl_xor(yp, 2); yp += __shfl_xor(yp, 4);
        if (q == 0) { const float y = yp + F.in[I_MD][head] * xs, zv = bf2f(Z[row * MIN + head * 64 + p]); GY[row * 3072 + 1024 + head * 64 + p] = (bf16)f2bf(y * siluf_(zv)); }
    }
}

__device__ __forceinline__ void p3_mixers(Frame& F) {
    for (int rep = 0; rep < P_SSDP; ++rep)
    for (int u = blockIdx.x; u < NBATCH * NH; u += F.G) { const int b = u & 7, head = u >> 3;
        ssd_prompt_mfma(F, b, head); }
    for (int rep = 0; rep < P_SSDS; ++rep) ssd_sample_waves(F);
    __syncthreads();
    for (int r_ = 0; r_ < P_S5P; ++r_)
    for (int u = blockIdx.x; u < G5 * 4; u += F.G) { const int x = u & 7, k = u >> 3, f = x * 8 + (k >> 2);
        s5_prompt_mfma(F, 4 * (f >> 2) + (k & 3), f & 3); }
    for (int r_ = 0; r_ < P_S5S; ++r_)
    for (int u = blockIdx.x * NWAVES + F.wave; u < MS * G5; u += F.G * NWAVES) s5_sample_unit(F, u >> 6, u & 63);
}
__device__ __forceinline__ void p5b_norm(Frame& F) {
    const float* MIX = WSP(float, WS_MIX); float* X1 = WSP(float, WS_X1); bf16* H = WSP(bf16, WS_H); const float* MOD = WSP(float, WS_MOD);
    const float* gpo = F.in[I_NPOM]; const float* gpf = F.in[I_NPF];
    for (int m = blockIdx.x * NWAVES + F.wave; m < MT; m += F.G * NWAVES) {
        const f32x4* xr = (const f32x4*)xrow(F, m) + F.lane; const f32x4* mx = (const f32x4*)(MIX + (size_t)m * DM) + F.lane; const float* mr = MOD + (size_t)modrow(m) * 6144;
        f32x4 v[4], x[4]; float s2 = 0.f;
#pragma unroll
        for (int j = 0; j < 4; ++j) { v[j] = mx[64 * j]; x[j] = xr[64 * j]; s2 += (v[j].x * v[j].x + v[j].y * v[j].y) + (v[j].z * v[j].z + v[j].w * v[j].w); }
        const float r1 = 1.0f / sqrtf(wave_sum(s2) * (1.f / DM) + EPS); float s3 = 0.f;
#pragma unroll
        for (int j = 0; j < 4; ++j) { const int c = 4 * F.lane + 256 * j; const f32x4 g = *(const f32x4*)(gpo + c), gt = *(const f32x4*)(mr + 2048 + c);
            x[j] = x[j] + gt * ((v[j] * r1) * g); *((f32x4*)(X1 + (size_t)m * DM) + F.lane + 64 * j) = x[j];
            s3 += (x[j].x * x[j].x + x[j].y * x[j].y) + (x[j].z * x[j].z + x[j].w * x[j].w); }
        const float r2 = 1.0f / sqrtf(wave_sum(s3) * (1.f / DM) + EPS);
        unsigned long long* o8 = (unsigned long long*)(H + (size_t)m * DM) + F.lane;
#pragma unroll
        for (int j = 0; j < 4; ++j) { const int c = 4 * F.lane + 256 * j; const f32x4 g = *(const f32x4*)(gpf + c), sh = *(const f32x4*)(mr + 3072 + c), sc = *(const f32x4*)(mr + 4096 + c);
            const f32x4 h = (x[j] * r2) * g * (sc + 1.0f) + sh;
            o8[64 * j] = (unsigned long long)pk2(h.x, h.y) | ((unsigned long long)pk2(h.z, h.w) << 32); }
    }
}
__device__ __forceinline__ void p8_out(Frame& F) {
    const float* FO = WSP(float, WS_FO); const float* X1 = WSP(float, WS_X1); const float* MOD = WSP(float, WS_MOD); const float* gpo = F.in[I_NPOF];
    for (int m = blockIdx.x * NWAVES + F.wave; m < MT; m += F.G * NWAVES) {
        const f32x4* fr = (const f32x4*)(FO + (size_t)m * DM) + F.lane; const f32x4* xr = (const f32x4*)(X1 + (size_t)m * DM) + F.lane; const float* mr = MOD + (size_t)modrow(m) * 6144;
        f32x4 v[4], x[4]; float s2 = 0.f;
#pragma unroll
        for (int j = 0; j < 4; ++j) { v[j] = fr[64 * j]; x[j] = xr[64 * j]; s2 += (v[j].x * v[j].x + v[j].y * v[j].y) + (v[j].z * v[j].z + v[j].w * v[j].w); }
        const float r1 = 1.0f / sqrtf(wave_sum(s2) * (1.f / DM) + EPS);
        f32x4* o = (f32x4*)(F.out + (m < MP ? O_YP + (size_t)m * DM : O_YS + (size_t)(m - MP) * DM)) + F.lane;
#pragma unroll
        for (int j = 0; j < 4; ++j) { const int c = 4 * F.lane + 256 * j; const f32x4 g = *(const f32x4*)(gpo + c), gt = *(const f32x4*)(mr + 5120 + c);
            o[64 * j] = x[j] + gt * ((v[j] * r1) * g); }
    }
}

__device__ __forceinline__ void small_tile(Frame& F, const bf16* A, int lda, const bf16* Bt, int ldb, int K, int rt, int ct, float (&v)[8]) {
    LAS float* RED = (LAS float*)F.lds;
    const int lane = F.lane, w = F.wave, r32 = lane & 31, hh = lane >> 5, kw = K >> 3;
    const bf16* ap = A + (size_t)(32 * rt + r32) * lda + w * kw + 8 * hh; const bf16* bp = Bt + (size_t)(32 * ct + r32) * ldb + w * kw + 8 * hh;
    f32x16 acc;
#pragma unroll
    for (int r = 0; r < 16; ++r) acc[r] = 0.f;
#pragma unroll 8
    for (int ks = 0; ks < (kw >> 4); ++ks) { const bf16x8 a = *(const bf16x8*)(ap + 16 * ks), bb = *(const bf16x8*)(bp + 16 * ks); acc = __builtin_amdgcn_mfma_f32_32x32x16_bf16(a, bb, acc, 0, 0, 0); }
    __syncthreads();
#pragma unroll
    for (int r = 0; r < 16; ++r) RED[(w * 32 + rowoff(r, hh)) * 33 + r32] = acc[r];
    __syncthreads();
    if (F.tid < 128) { const int row = F.tid >> 2, c8 = F.tid & 3;
#pragma unroll
        for (int e = 0; e < 8; ++e) { float sum = 0.f;
#pragma unroll
            for (int ww = 0; ww < 8; ++ww) sum += RED[(ww * 32 + row) * 33 + c8 * 8 + e];
            v[e] = sum; } }
}
template <class Epi> __device__ __forceinline__ void small_gemm(Frame& F, const bf16* A, const bf16* Bt, int K, const Epi& E) {
    for (int t = blockIdx.x; t < 128; t += F.G) { float v[8]; small_tile(F, A, K, Bt, K, K, t >> 5, t & 31, v);
        if (F.tid < 128) E.chunk(MP + 32 * (t >> 5) + (F.tid >> 2), 32 * (t & 31) + 8 * (F.tid & 3), v); }
    __syncthreads();
}
__device__ __forceinline__ void small_merge(Frame& F) {
    const bf16* GY = WSP(bf16, WS_GY) + (size_t)MP * 3072; const bf16* WB = WSP(bf16, WS_WBR); const bf16* GA = WSP(bf16, WS_GA); const bf16* GB = WSP(bf16, WS_GB); bf16* O = WSP(bf16, WS_MERGED);
    LAS float* RSs = (LAS float*)(F.lds + 40960);
    for (int t = blockIdx.x; t < 128; t += F.G) { const int rt = t >> 5, ct = t & 31;
        {   const int rr = F.tid >> 4, seg = F.tid & 15; const bf16* yp = GY + (size_t)(32 * rt + rr) * 3072 + 1024 + seg * 128; float q2 = 0.f;
#pragma unroll 4
            for (int i = 0; i < 16; ++i) { const v4u w4 = *(const v4u*)(yp + 8 * i); float f[8]; unpack8(w4, f);
                q2 += (f[0] * f[0] + f[1] * f[1]) + (f[2] * f[2] + f[3] * f[3]) + (f[4] * f[4] + f[5] * f[5]) + (f[6] * f[6] + f[7] * f[7]); }
            q2 += __shfl_xor(q2, 1); q2 += __shfl_xor(q2, 2); q2 += __shfl_xor(q2, 4); q2 += __shfl_xor(q2, 8);
            if (seg == 0) RSs[rr] = 1.0f / sqrtf(q2 * (1.f / MIN) + EPS); }
        float v1[8], v2[8];
        small_tile(F, GY, 3072, WB, 3072, 1024, rt, ct, v1);
        small_tile(F, GY + 1024, 3072, WB + 1024, 3072, 2048, rt, ct, v2);
        if (F.tid < 128) { const int lr = F.tid >> 2, row = MP + 32 * rt + lr, col0 = 32 * ct + 8 * (F.tid & 3); const size_t off = (size_t)row * 1024 + col0; const float r = RSs[lr];
            float ga[8], gb[8], o[8]; unpack8(*(const v4u*)(GA + off), ga); unpack8(*(const v4u*)(GB + off), gb);
#pragma unroll
            for (int e = 0; e < 8; ++e) o[e] = ga[e] * v1[e] + gb[e] * r * v2[e];
            v4u ow; ow.x = pk2(o[0], o[1]); ow.y = pk2(o[2], o[3]); ow.z = pk2(o[4], o[5]); ow.w = pk2(o[6], o[7]);
            *(v4u*)(O + off) = ow; }
        __syncthreads();
    }
}

constexpr int N_PHASES = 12;
__global__ void __launch_bounds__(NWAVES * 64, 2) mk_fwd(Args args) {
    extern __shared__ __attribute__((aligned(16))) unsigned char lds[];
    Frame F;
    F.lds = (LAS unsigned char*)lds; F.MISC = (volatile LAS unsigned*)(F.lds + MISC_OFF);
    F.tid = threadIdx.x; F.lane = F.tid & 63; F.wave = __builtin_amdgcn_readfirstlane(F.tid >> 6); F.G = gridDim.x;
    F.in = args.in; F.out = args.out; F.ws = args.ws; F.ctl = (gu32*)(args.ws + WS_CTL);
    if (F.tid < 32) ((LAS unsigned*)(F.lds + MISC_OFF))[F.tid] = 0u;
    __syncthreads();
    XcdBarrier bar; bar.bar = (unsigned*)(F.ctl + CW_BAR); bar.x = 0; bar.st = nullptr;
    if (MK_ONE_LAUNCH) bar = xcd_barrier_post((unsigned*)(F.ctl + CW_BAR), F.MISC + 8);
    const int lo = args.ph_lo, hi = args.ph_hi;
#define IN(k) (lo <= (k) && (k) < hi)
#define SEAM(k) do { if (IN(k) && IN((k) + 1)) xcd_barrier(bar); } while (0)
    typedef pg8::StaticOrder SO;
    if (IN(0)) { for (int r_ = 0; r_ < P_MOD; ++r_) p0_mod(F); p0_s5consts(F); for (int r_ = 0; r_ < P_TAB; ++r_) p0_s5tables(F); for (int r_ = 0; r_ < P_WCVT; ++r_) p0_weights(F); } SEAM(0);
    if (IN(1)) { for (int r_ = 0; r_ < P_NORM1; ++r_) p1_norm(F); } SEAM(1);
    for (int rg_ = 0; rg_ < P_G2; ++rg_) if (IN(2)) { pg8::Gemm g{WSP(bf16, WS_H), WSP(bf16, WS_WIN), MPAD, NPROJ, 1024}; SO S; S.init(MPAD, NPROJ, F.G, (int)blockIdx.x);
        pg8::EpiProj E{WSP(bf16, WS_U), WSP(bf16, WS_Z), WSP(bf16, WS_XBC), WSP(bf16, WS_GA), WSP(bf16, WS_GB), WSP(float, WS_DT), F.in[I_DTB]};
        pg8::gemm_phase<pg8::EpiProj, SO, true, true>(F.lds, g, S, E); } SEAM(2);
    if (IN(3)) { for (int r_ = 0; r_ < P_CONV; ++r_) p_conv(F); } SEAM(3);
    if (IN(4)) { p3_mixers(F); } SEAM(4);
    for (int rg_ = 0; rg_ < P_G6; ++rg_) if (IN(5)) { pg8::Gemm g{WSP(bf16, WS_YA), WSP(bf16, WS_WGLU), MP, 1024, 1024}; SO S; S.init(MP, 1024, F.G, (int)blockIdx.x);
        pg8::EpiGate<0> E{WSP(bf16, WS_GY), WSP(bf16, WS_YA), nullptr, F.in[I_BGLU], nullptr, 3072};
        pg8::gemm_phase<pg8::EpiGate<0>, SO, true, true>(F.lds, g, S, E); small_gemm(F, WSP(bf16, WS_YA) + (size_t)MP * 1024, WSP(bf16, WS_WGLU), 1024, E); } SEAM(5);
    for (int rg_ = 0; rg_ < P_G8; ++rg_) if (IN(6)) {
        pg8::Gemm g{WSP(bf16, WS_GY), WSP(bf16, WS_WBR), MP, 1024, 3072}; SO S; S.init(MP, 1024, F.G, (int)blockIdx.x);
        LAS float* rsl = (LAS float*)(F.lds + 131072);
        { pg8::Unit u0; if (S.next(0, u0) && F.tid < 256) { const float* q = WSP(float, WS_SSQ) + (size_t)(u0.pm * 256 + F.tid) * 32; float sum = 0.f;
#pragma unroll
                for (int j = 0; j < 8; ++j) { const f32x4 v = *(const f32x4*)(q + 4 * j); sum += (v[0] + v[1]) + (v[2] + v[3]); }
                rsl[F.tid] = 1.0f / sqrtf(sum * (1.f / MIN) + EPS); } }
        __syncthreads();
        pg8::EpiMerge E{WSP(bf16, WS_MERGED), WSP(bf16, WS_GA), WSP(bf16, WS_GB), rsl, 1024 / 64};
        pg8::gemm_phase<pg8::EpiMerge, SO, true, true>(F.lds, g, S, E); small_merge(F); } SEAM(6);
    for (int rg_ = 0; rg_ < P_G9; ++rg_) if (IN(7)) { pg8::Gemm g{WSP(bf16, WS_MERGED), WSP(bf16, WS_WOUT), MP, 1024, 1024}; SO S; S.init(MP, 1024, F.G, (int)blockIdx.x);
        pg8::EpiF32 E{WSP(float, WS_MIX)};
        pg8::gemm_phase<pg8::EpiF32, SO, true, true>(F.lds, g, S, E); small_gemm(F, WSP(bf16, WS_MERGED) + (size_t)MP * 1024, WSP(bf16, WS_WOUT), 1024, E); } SEAM(7);
    if (IN(8)) { for (int r_ = 0; r_ < P_P5B; ++r_) p5b_norm(F); } SEAM(8);
    for (int rg_ = 0; rg_ < P_G11; ++rg_) if (IN(9)) { pg8::Gemm g{WSP(bf16, WS_H), WSP(bf16, WS_WFI), MPAD, 2 * DFF, 1024}; SO S; S.init(MPAD, 2 * DFF, F.G, (int)blockIdx.x);
        pg8::EpiSwiglu E{WSP(bf16, WS_FA)};
        pg8::gemm_phase<pg8::EpiSwiglu, SO, true, true>(F.lds, g, S, E); } SEAM(9);
    for (int rg_ = 0; rg_ < P_G12; ++rg_) if (IN(10)) { pg8::Gemm g{WSP(bf16, WS_FA), WSP(bf16, WS_WFO), MP, 1024, DFF}; SO S; S.init(MP, 1024, F.G, (int)blockIdx.x);
        pg8::EpiF32 E{WSP(float, WS_FO)};
        pg8::gemm_phase<pg8::EpiF32, SO, true, true>(F.lds, g, S, E); small_gemm(F, WSP(bf16, WS_FA) + (size_t)MP * DFF, WSP(bf16, WS_WFO), DFF, E); } SEAM(10);
    if (IN(11)) { for (int r_ = 0; r_ < P_P8; ++r_) p8_out(F); }
#undef IN
#undef SEAM
}

extern "C" void kernel_launch(void* const* d_in, const int* in_sizes, int n_in, void* d_out, int out_size, void* d_ws, size_t ws_size, hipStream_t stream) {
    static int grid = 0;
    if (grid == 0) {
        if (n_in != N_IN || (size_t)out_size != O_END || ws_size < WS_END) { fprintf(stderr, "kernel_launch: unexpected shapes: n_in %d out %d ws %zu (need %zu / %zu)\n", n_in, out_size, ws_size, (size_t)O_END, (size_t)WS_END); grid = -1; return; }
        int dev = 0, cus = 0, per_cu = 0;
        if (hipGetDevice(&dev) != hipSuccess || hipDeviceGetAttribute(&cus, hipDeviceAttributeMultiprocessorCount, dev) != hipSuccess) { grid = -1; return; }
        if (hipFuncSetAttribute((const void*)mk_fwd, hipFuncAttributeMaxDynamicSharedMemorySize, LDS_BYTES) != hipSuccess) { fprintf(stderr, "kernel_launch: hipFuncSetAttribute failed\n"); grid = -1; return; }
        if (hipOccupancyMaxActiveBlocksPerMultiprocessor(&per_cu, (const void*)mk_fwd, NWAVES * 64, LDS_BYTES) != hipSuccess || per_cu < 1) { fprintf(stderr, "kernel_launch: occupancy query says %d blocks per CU\n", per_cu); per_cu = 1; }
        (void)hipGetLastError();
        if (cus != 256) { fprintf(stderr, "kernel_launch: built for a 256-CU device (one 256x256 unit per workgroup in the N = 1024 GEMM phases); found %d CUs; nothing launched\n", cus); grid = -1; return; }
        grid = cus;
    }
    if (grid < 0) return;
    (void)hipMemsetAsync((char*)d_ws + WS_CTL, 0, CTL_ZERO_BYTES, stream);
    Args a{};
    for (int i = 0; i < N_IN; ++i) a.in[i] = (const float*)d_in[i];
    a.out = (float*)d_out; a.ws = (unsigned char*)d_ws;
    if (MK_ONE_LAUNCH) { a.ph_lo = 0; a.ph_hi = N_PHASES; hipLaunchKernelGGL(mk_fwd, dim3(grid), dim3(NWAVES * 64), LDS_BYTES, stream, a); }
    else for (int p = 0; p < N_PHASES; ++p) { a.ph_lo = p; a.ph_hi = p + 1; hipLaunchKernelGGL(mk_fwd, dim3(grid), dim3(NWAVES * 64), LDS_BYTES, stream, a); }
}
```
